# Optimizing an MI355X kernel written in HIP

```python
import math
import jax, jax.numpy as jnp
from jax import lax
import numpy as np

D_MODEL = 1024
BATCH = 8
SEQ = 8192
DEPTH = 1

N_META = 16
ATTN_HEADS = 4
ATTN_HEAD_DIM = 64
ATTN_VALUE_DIM = 2 * ATTN_HEAD_DIM
ATTN_WIDTH = ATTN_HEADS * ATTN_VALUE_DIM
CONV_WIDTH = D_MODEL - ATTN_WIDTH
CONV_K = 3
MIX_WIDTH = ATTN_WIDTH + CONV_WIDTH
IN_PROJ_WIDTH = 3 * ATTN_WIDTH + 3 * CONV_WIDTH
N_EXPERTS = 16
EC_CAPACITY_FACTOR = 2
D_FF_EXPERT = 2 * D_MODEL
ROPE_THETA = 10000.0
Q_BLOCK = 128
NORM_EPS = 1e-6

kernel_name = "hymba_diffattn_shortconv_ec_moe"


def rms_norm(x, g):
    xf = x.astype(jnp.float32)
    y = xf * lax.rsqrt(jnp.mean(xf * xf, axis=-1, keepdims=True) + NORM_EPS)
    return (y * g.astype(jnp.float32)).astype(x.dtype)


def rope_tables(n):
    d = ATTN_HEAD_DIM
    inv_freq = ROPE_THETA ** (-jnp.arange(0, d, 2, dtype=jnp.float32) / d)
    ang = jnp.arange(n, dtype=jnp.float32)[:, None] * inv_freq[None, :]
    ang = jnp.concatenate([ang, ang], axis=-1)
    return jnp.cos(ang), jnp.sin(ang)


def apply_rope(x, cos, sin):
    half = x.shape[-1] // 2
    x1, x2 = x[..., :half], x[..., half:]
    rot = jnp.concatenate([-x2, x1], axis=-1)
    return (x * cos + rot * sin).astype(x.dtype)


def diff_attention_group(q, k, v, lq1, lk1, lq2, lk2, subln_g, lam_init, cos, sin):
    B, L, _ = q.shape
    Lp = cos.shape[0]
    H, d = ATTN_HEADS, ATTN_HEAD_DIM
    pad = Lp - L
    q = jnp.pad(q.reshape(B, L, H, 2, d), ((0, 0), (0, pad), (0, 0), (0, 0), (0, 0)))
    k = jnp.pad(k.reshape(B, L, H, 2, d), ((0, 0), (0, pad), (0, 0), (0, 0), (0, 0)))
    v = jnp.pad(v.reshape(B, L, H, 2 * d), ((0, 0), (0, pad), (0, 0), (0, 0)))
    q = apply_rope(q.transpose(0, 2, 3, 1, 4), cos, sin)
    k = apply_rope(k.transpose(0, 2, 3, 1, 4), cos, sin)
    v32 = v.transpose(0, 2, 1, 3).astype(jnp.float32)

    lam = (jnp.exp(jnp.sum(lq1.astype(jnp.float32) * lk1.astype(jnp.float32)))
           - jnp.exp(jnp.sum(lq2.astype(jnp.float32) * lk2.astype(jnp.float32)))
           + lam_init)
    key_valid = jnp.arange(Lp) < L
    scale = d ** -0.5
    n_blk = Lp // Q_BLOCK
    qb = jnp.moveaxis(q.reshape(B, H, 2, n_blk, Q_BLOCK, d), 3, 0)

    def one_block(qi):
        s = jnp.einsum('bhiqd,bhikd->bhiqk', qi, k,
                       preferred_element_type=jnp.float32) * scale
        s = jnp.where(key_valid, s, jnp.finfo(jnp.float32).min)
        p = jax.nn.softmax(s, axis=-1)
        a = p[:, :, 0] - lam * p[:, :, 1]
        return jnp.einsum('bhqk,bhkv->bhqv', a, v32)

    o = lax.map(one_block, qb)
    o = o.transpose(1, 0, 3, 2, 4).reshape(B, Lp, H, 2 * d)[:, :L]
    o = rms_norm(o, subln_g) * (1.0 - lam_init)
    return o.reshape(B, L, ATTN_WIDTH).astype(q.dtype)


def centred_depthwise_conv(u, w):
    L = u.shape[1]
    half = CONV_K // 2
    up = jnp.pad(u, ((0, 0), (half, half), (0, 0)))
    return sum(w[j] * up[:, j:j + L] for j in range(CONV_K))


def expert_choice_ffn(h, w_router, w_gate, w_up, w_down):
    B, L, D = h.shape
    cap = EC_CAPACITY_FACTOR * L // N_EXPERTS

    def one_group(hs):
        logits = jnp.einsum('ld,de->le', hs, w_router, preferred_element_type=jnp.float32)
        aff = jax.nn.softmax(logits, axis=-1)
        g, idx = lax.top_k(aff.T, cap)
        xg = hs[idx]
        a = jnp.einsum('ecd,edf->ecf', xg, w_gate)
        u = jnp.einsum('ecd,edf->ecf', xg, w_up)
        y = jnp.einsum('ecf,efd->ecd', jax.nn.silu(a) * u, w_down)
        y = y * g[..., None].astype(y.dtype)
        out = jnp.zeros((L, D), y.dtype).at[idx.reshape(-1)].add(y.reshape(-1, D))
        return out.astype(hs.dtype)

    return lax.map(one_group, h)


def setup_inputs(seed: int = 0) -> dict:
    key = jax.random.key(seed)
    ks = jax.random.split(key, 20)
    f32 = jnp.float32
    nrm = lambda k, shape, s: jax.random.normal(k, shape, f32) * s
    gain = lambda k, shape: 1.0 + 0.02 * jax.random.normal(k, shape, f32)
    return {
        "x": nrm(ks[0], (BATCH, SEQ, D_MODEL), 1.0),
        "meta_tokens": nrm(ks[1], (N_META, D_MODEL), 1.0),
        "mix_norm_g": gain(ks[2], (DEPTH, D_MODEL)),
        "w_in": nrm(ks[3], (DEPTH, D_MODEL, IN_PROJ_WIDTH), D_MODEL ** -0.5),
        "conv_w": nrm(ks[4], (DEPTH, CONV_K, CONV_WIDTH), CONV_K ** -0.5),
        "lambda_q1": nrm(ks[5], (DEPTH, ATTN_HEAD_DIM), 0.1),
        "lambda_k1": nrm(ks[6], (DEPTH, ATTN_HEAD_DIM), 0.1),
        "lambda_q2": nrm(ks[7], (DEPTH, ATTN_HEAD_DIM), 0.1),
        "lambda_k2": nrm(ks[8], (DEPTH, ATTN_HEAD_DIM), 0.1),
        "attn_subln_g": gain(ks[9], (DEPTH, ATTN_VALUE_DIM)),
        "w_out": nrm(ks[10], (DEPTH, MIX_WIDTH, D_MODEL), MIX_WIDTH ** -0.5),
        "ffn_norm_g": gain(ks[11], (DEPTH, D_MODEL)),
        "w_router": nrm(ks[12], (DEPTH, D_MODEL, N_EXPERTS), D_MODEL ** -0.5),
        "w_gate": nrm(ks[13], (DEPTH, N_EXPERTS, D_MODEL, D_FF_EXPERT), D_MODEL ** -0.5),
        "w_up": nrm(ks[14], (DEPTH, N_EXPERTS, D_MODEL, D_FF_EXPERT), D_MODEL ** -0.5),
        "w_down": nrm(ks[15], (DEPTH, N_EXPERTS, D_FF_EXPERT, D_MODEL), D_FF_EXPERT ** -0.5),
        "final_norm_g": gain(ks[16], (D_MODEL,)),
    }


def reference(x, meta_tokens, mix_norm_g, w_in, conv_w, lambda_q1, lambda_k1, lambda_q2,
              lambda_k2, attn_subln_g, w_out, ffn_norm_g, w_router, w_gate, w_up, w_down,
              final_norm_g):
    B = x.shape[0]
    meta = jnp.broadcast_to(meta_tokens.astype(x.dtype)[None], (B, N_META, D_MODEL))
    h = jnp.concatenate([meta, x], axis=1)
    L = h.shape[1]
    Lp = -(-L // Q_BLOCK) * Q_BLOCK
    cos, sin = rope_tables(Lp)
    splits = [ATTN_WIDTH, 2 * ATTN_WIDTH, 3 * ATTN_WIDTH,
              3 * ATTN_WIDTH + CONV_WIDTH, 3 * ATTN_WIDTH + 2 * CONV_WIDTH]

    for l in range(DEPTH):
        lam_init = 0.8 - 0.6 * math.exp(-0.3 * l)
        hn = rms_norm(h, mix_norm_g[l])
        proj = jnp.einsum('bld,dp->blp', hn, w_in[l])
        q, k, v, cx, cb, cc = jnp.split(proj, splits, axis=-1)
        attn = diff_attention_group(q, k, v, lambda_q1[l], lambda_k1[l], lambda_q2[l],
                                    lambda_k2[l], attn_subln_g[l], lam_init, cos, sin)
        conv = cb * centred_depthwise_conv(cc * cx, conv_w[l])
        mixed = jnp.concatenate([attn, conv.astype(attn.dtype)], axis=-1)
        h = h + jnp.einsum('blm,md->bld', mixed, w_out[l])
        h = h + expert_choice_ffn(rms_norm(h, ffn_norm_g[l]), w_router[l], w_gate[l],
                                  w_up[l], w_down[l])

    y = rms_norm(h, final_norm_g)
    return y[:, N_META:, :]
```

```cpp
#include <hip/hip_runtime.h>
#include <cstdio>
#include <cstdint>
#include <cmath>
__device__ __forceinline__ int hw_lane() { int l; asm volatile("v_mbcnt_lo_u32_b32 %0, -1, 0\n\tv_mbcnt_hi_u32_b32 %0, -1, %0" : "=v"(l)); return l; }
namespace pg8 {
#define PG8_LAS __attribute__((address_space(3)))
typedef unsigned short bf16_t;
typedef short bf16x8 __attribute__((ext_vector_type(8)));
typedef float f32x4 __attribute__((ext_vector_type(4)));
typedef unsigned u32x4 __attribute__((ext_vector_type(4)));
typedef int v4i_t __attribute__((ext_vector_type(4)));
typedef int v8i_t __attribute__((ext_vector_type(8)));
constexpr int BM = 256, BK = 64, HALF = 128, HTB = HALF * BK * 2  , STAGE_BYTES = 8 * HTB, NXCD = 8, WGM = 4;

__host__ __device__ __forceinline__ int lds_byte(int r, int c) { const int st = (r >> 4) * 2 + (c >> 5), rr = r & 15, cc = c & 31, ob = rr * 64 + cc * 2; return st * 1024 + (ob ^ (((ob >> 9) & 1) << 5)); }
__host__ __device__ __forceinline__ void stage_rc(int b, int& R, int& C) { const int st = b / 1024, sb = b % 1024, swz = sb ^ (((sb >> 9) & 1) << 5); R = (st >> 1) * 16 + swz / 64; C = (st & 1) * 32 + (swz % 64) / 2; }
__host__ __device__ __forceinline__ int perm32(int rho) { const int n = rho >> 4, i = rho & 15; return 8 * (i >> 2) + 4 * n + (i & 3); }

struct Unit { int pm, pn; };
struct Gemm { const bf16_t* A; const bf16_t* Bt; int K; };

struct StaticOrder {
    int nM, nN, nwg, G, c;
    __host__ __device__ void init(int nM_, int nN_, int G_, int c_) { nM = nM_; nN = nN_; nwg = nM * nN; G = G_; c = c_; }
    __host__ __device__ bool next(int i, Unit& u) const {
        const long L = (long)i * G + c; if (L >= nwg) return false;
        int wgid = (int)L; { const int q = nwg / NXCD, r = nwg % NXCD, xcd = wgid % NXCD, off = wgid / NXCD; wgid = (xcd < r ? xcd * (q + 1) : r * (q + 1) + (xcd - r) * q) + off; }
        const int nig = WGM * nN, gid = wgid / nig, fm = gid * WGM, gsz = (nM - fm) < WGM ? (nM - fm) : WGM;
        u.pm = fm + ((wgid % nig) % gsz); u.pn = (wgid % nig) / gsz; return true;
    }
};
struct ExpertOrder {
    int NT, G, c;
    __host__ __device__ void init(int NT_, int G_, int c_) { NT = NT_; G = G_; c = c_; }
    __host__ __device__ bool next(int i, Unit& u) const {
        const int per = 32 * NT;
        int e, jj;
        if (G == 256) { const int xcd = c & 7, ci = c >> 3, j = i * 32 + ci; if (j >= 2 * per) return false; e = 2 * xcd + j / per; jj = j % per; }
        else { const long L = (long)i * G + c; if (L >= 16L * per) return false; e = (int)(L / per); jj = (int)(L % per); }
        const int blk = 8 * NT, rgp = jj / blk, w = jj % blk, cg = w >> 5, v = w & 31; const int rt = 8 * rgp + (v & 7), ct = cg * 4 + (v >> 3);
        u.pm = e * 33 + rt; u.pn = e * NT + ct; return true;
    }
};
struct RowIdentity { __device__ __forceinline__ unsigned row(int pm, int h, int R) const { return (unsigned)(pm * BM + h * HALF + R); } };
struct RowGather { const int* idx; __device__ __forceinline__ unsigned row(int pm, int h, int R) const { return (unsigned)idx[pm * BM + h * HALF + R]; } };

__device__ __forceinline__ unsigned cvt_pk_bf16(float lo, float hi) { unsigned r; asm volatile("v_cvt_pk_bf16_f32 %0, %1, %2" : "=v"(r) : "v"(lo), "v"(hi)); return r; }
__device__ __forceinline__ u32x4 pack8(const f32x4 v0, const f32x4 v1) { u32x4 w; w.x = cvt_pk_bf16(v0[0], v0[1]); w.y = cvt_pk_bf16(v0[2], v0[3]); w.z = cvt_pk_bf16(v1[0], v1[1]); w.w = cvt_pk_bf16(v1[2], v1[3]); return w; }


template <class Epi, class Sched, class AMap, bool ALIGN_EPI, bool FP8 = false>
__device__ __forceinline__ void gemm_phase(PG8_LAS unsigned char* lds, const Gemm g, const Sched& S, const Epi& E, const AMap& AM, const int wid) {
    const int lane = hw_lane(), tid = wid * 64 + lane, wr = wid >> 2, wc = wid & 3, fr = lane & 15, fq = lane >> 4;
    const int K = g.K, nt = K / BK;
    unsigned voffB[2];
#pragma unroll
    for (int i = 0; i < 2; ++i) { int R, C; stage_rc(tid * 16 + i * 8192, R, C); const int Rb = Epi::PERM ? ((R & ~31) + perm32(R & 31)) : R;
        voffB[i] = (unsigned)(Rb * K + C) * 2u; }
    const size_t kstep = (size_t)(BK * 2);
    const size_t hstep = (size_t)HALF * K * 2;
    const size_t tstep = 2 * hstep;
    const unsigned ldsw = (unsigned)wid * 1024u;
    const int aoff = lds_byte(wr * 64 + fr, fq * 8), boff = lds_byte(wc * 32 + fr, fq * 8);
#define PG8_SA(b, h) (((b) * 2 + (h)) * HTB)
#define PG8_SB(b, h) ((4 + (b) * 2 + (h)) * HTB)
#define PG8_STAGE(bufoff, gbase, voff) do { _Pragma("unroll") for (int _i = 0; _i < 2; ++_i) \
        __builtin_amdgcn_global_load_lds((const unsigned*)((const char*)(gbase) + (voff)[_i]), (PG8_LAS unsigned*)(lds + (bufoff) + ldsw + _i * 8192), 16, 0, 0); } while (0)
#define PG8_LD8(p) __builtin_shufflevector(*(const PG8_LAS v4i_t*)(p), *(const PG8_LAS v4i_t*)((p) + 1024), 0, 1, 2, 3, 4, 5, 6, 7)
#define PG8_LDA(dst, b, h) do { if constexpr (FP8) { _Pragma("unroll") for (int m = 0; m < 4; ++m) dst##8[m] = PG8_LD8(lds + PG8_SA(b, h) + aoff + m * 2048); } \
        else { _Pragma("unroll") for (int m = 0; m < 4; ++m) _Pragma("unroll") for (int k = 0; k < 2; ++k) dst[m][k] = *(const PG8_LAS bf16x8*)(lds + PG8_SA(b, h) + aoff + m * 2048 + k * 1024); } } while (0)
#define PG8_LDB(dst, b, h) do { if constexpr (FP8) { _Pragma("unroll") for (int n = 0; n < 2; ++n) dst##8[n] = PG8_LD8(lds + PG8_SB(b, h) + boff + n * 2048); } \
        else { _Pragma("unroll") for (int n = 0; n < 2; ++n) _Pragma("unroll") for (int k = 0; k < 2; ++k) dst[n][k] = *(const PG8_LAS bf16x8*)(lds + PG8_SB(b, h) + boff + n * 2048 + k * 1024); } } while (0)
#define PG8_MMA(ai, bj, At, Bt) do { __builtin_amdgcn_s_setprio(1); \
        if constexpr (FP8) { _Pragma("unroll") for (int m = 0; m < 4; ++m) _Pragma("unroll") for (int n = 0; n < 2; ++n) \
            asm volatile("v_mfma_scale_f32_16x16x128_f8f6f4 %0, %1, %2, %0, %3, %4 op_sel_hi:[0,0,0]" : "+v"(acc[ai][bj][m][n]) : "v"(Bt##8[n]), "v"(At##8[m]), "v"(wscale_), "v"(ascale_)); } \
        else { _Pragma("unroll") for (int m = 0; m < 4; ++m) _Pragma("unroll") for (int n = 0; n < 2; ++n) _Pragma("unroll") for (int k = 0; k < 2; ++k) \
            acc[ai][bj][m][n] = __builtin_amdgcn_mfma_f32_16x16x32_bf16(Bt[n][k], At[m][k], acc[ai][bj][m][n], 0, 0, 0); } \
        __builtin_amdgcn_s_setprio(0); } while (0)
#define PG8_WAIT_V(n) asm volatile("s_waitcnt vmcnt(" #n ")" ::: "memory")
#define PG8_WAIT_L(n) asm volatile("s_waitcnt lgkmcnt(" #n ")" ::: "memory")
#define PG8_BAR __builtin_amdgcn_s_barrier()
#define PG8_SCHED __builtin_amdgcn_sched_barrier(0)
#define PG8_ARAW(dst, u_) do { _Pragma("unroll") for (int _h = 0; _h < 2; ++_h) _Pragma("unroll") for (int _i = 0; _i < 2; ++_i) { int R_, C_; stage_rc(tid * 16 + _i * 8192, R_, C_); dst[_h][_i] = AM.row((u_).pm, _h, R_); } } while (0)
#define PG8_AOFS(dst, raw) do { _Pragma("unroll") for (int _h = 0; _h < 2; ++_h) _Pragma("unroll") for (int _i = 0; _i < 2; ++_i) { int R_, C_; stage_rc(tid * 16 + _i * 8192, R_, C_); dst[_h][_i] = (raw[_h][_i] * (unsigned)K + (unsigned)C_) * 2u; } } while (0)
    Unit cur, nxt; int ui = 0;
    if (!S.next(0, cur)) return;
    f32x4 acc[2][2][4][2];
#pragma unroll
    for (int a = 0; a < 2; ++a)
#pragma unroll
        for (int b = 0; b < 2; ++b)
#pragma unroll
            for (int m = 0; m < 4; ++m)
#pragma unroll
                for (int n = 0; n < 2; ++n) acc[a][b][m][n] = (f32x4){0.f, 0.f, 0.f, 0.f};
    const int wscale_ = Epi::WSCALE, ascale_ = 0x7f7f7f7f;
    bf16x8 At[4][2], B0[2][2], B1[2][2]; v8i_t At8[4], B08[2], B18[2];
    unsigned voA[2][2], rawN[2][2];
    PG8_ARAW(rawN, cur); PG8_AOFS(voA, rawN);
    const char* const Ab = (const char*)g.A;
    const char* cB = (const char*)g.Bt + (size_t)cur.pn * tstep;
    PG8_STAGE(PG8_SB(0, 0), cB, voffB); PG8_STAGE(PG8_SB(0, 1), cB + hstep, voffB); PG8_STAGE(PG8_SA(0, 0), Ab, voA[0]); PG8_STAGE(PG8_SA(0, 1), Ab, voA[1]);
    if (wr == 1) PG8_BAR;
    PG8_WAIT_V(2); PG8_BAR;
    PG8_STAGE(PG8_SB(1, 0), cB + kstep, voffB); PG8_STAGE(PG8_SA(1, 0), Ab + kstep, voA[0]); PG8_STAGE(PG8_SB(1, 1), cB + hstep + kstep, voffB);
    PG8_WAIT_V(6); PG8_BAR;
    for (;;) {
        const bool has_next = S.next(ui + 1, nxt);
        if (has_next) { PG8_ARAW(rawN, nxt); }
        const char* nB = has_next ? (const char*)g.Bt + (size_t)nxt.pn * tstep : cB;
#pragma unroll 1
        for (int t = 0; t < nt; t += 2) {
            const bool last = (t == nt - 2);
            const char* a1 = Ab + (size_t)(t + 1) * kstep;
            const char* a2 = last ? Ab : Ab + (size_t)(t + 2) * kstep; const char* b2 = last ? nB : cB + (size_t)(t + 2) * kstep;
            const char* a3 = a2 + kstep; const char* b3 = b2 + kstep;
            unsigned v2[2][2];
            if (last) { asm volatile("" ::: "memory"); PG8_AOFS(v2, rawN); }
            else {
#pragma unroll
                for (int _h = 0; _h < 2; ++_h)
#pragma unroll
                    for (int _i = 0; _i < 2; ++_i) v2[_h][_i] = voA[_h][_i]; }
            PG8_LDB(B0, 0, 0); PG8_LDB(B1, 0, 1); PG8_SCHED; PG8_LDA(At, 0, 0); PG8_STAGE(PG8_SA(1, 1), a1, voA[1]);
            PG8_WAIT_V(8); PG8_WAIT_L(0); PG8_BAR; PG8_MMA(0, 0, At, B0); PG8_MMA(0, 1, At, B1); PG8_BAR; PG8_SCHED;
            PG8_LDA(At, 0, 1); PG8_STAGE(PG8_SB(0, 0), b2, voffB); PG8_STAGE(PG8_SB(0, 1), b2 + hstep, voffB); PG8_STAGE(PG8_SA(0, 0), a2, v2[0]);
            PG8_WAIT_V(8); PG8_WAIT_L(0); PG8_BAR; PG8_MMA(1, 0, At, B0); PG8_MMA(1, 1, At, B1); PG8_BAR; PG8_SCHED;
            PG8_LDB(B0, 1, 0); PG8_LDB(B1, 1, 1); PG8_SCHED; PG8_LDA(At, 1, 0); PG8_STAGE(PG8_SA(0, 1), a2, v2[1]);
            PG8_WAIT_V(8); PG8_WAIT_L(0); PG8_BAR; PG8_MMA(0, 0, At, B0); PG8_MMA(0, 1, At, B1); PG8_BAR; PG8_SCHED;
            PG8_LDA(At, 1, 1); PG8_STAGE(PG8_SB(1, 0), b3, voffB); PG8_STAGE(PG8_SB(1, 1), b3 + hstep, voffB); PG8_STAGE(PG8_SA(1, 0), a3, v2[0]);
            PG8_WAIT_V(8); PG8_WAIT_L(0); PG8_BAR; PG8_MMA(1, 0, At, B0); PG8_MMA(1, 1, At, B1); PG8_BAR; PG8_SCHED;
        }
        if constexpr (ALIGN_EPI) { if (wr == 0) PG8_BAR; }
        if constexpr (FP8) asm volatile("s_nop 15\n\ts_nop 15" ::: "memory");
        E(acc, cur, wr, wc, fr, fq);
        if (!has_next) break;
#pragma unroll
        for (int a = 0; a < 2; ++a)
#pragma unroll
            for (int b = 0; b < 2; ++b)
#pragma unroll
                for (int m = 0; m < 4; ++m)
#pragma unroll
                    for (int n = 0; n < 2; ++n) acc[a][b][m][n] = (f32x4){0.f, 0.f, 0.f, 0.f};
        cur = nxt; cB = nB; ++ui;
        PG8_AOFS(voA, rawN);
        if constexpr (ALIGN_EPI) { if (wr == 1) PG8_BAR; }
    }
    PG8_WAIT_V(0);
    if constexpr (!ALIGN_EPI) { if (wr == 0) PG8_BAR; }
    PG8_BAR;
#undef PG8_SA
#undef PG8_SB
#undef PG8_STAGE
#undef PG8_LDA
#undef PG8_LDB
#undef PG8_MMA
#undef PG8_LD8
#undef PG8_WAIT_V
#undef PG8_WAIT_L
#undef PG8_BAR
#undef PG8_SCHED
#undef PG8_ARAW
#undef PG8_AOFS
}
}
constexpr int D = 1024, BATCH = 8, SEQ = 8192, NMETA = 16, LSEQ = SEQ + NMETA;
constexpr int RX = BATCH * SEQ;
constexpr int RMETA = RX;
constexpr int RV = RX + BATCH * NMETA;
constexpr int RP = 257 * 256;
constexpr int AW = 512, CWID = 512, NPROJ = 3072;
constexpr int NEXP = 16, CAP = 1026, FF = 2048;
constexpr int EROWS = BATCH * CAP;
constexpr int EPAD = 33 * 256;
constexpr int KV_TILES = 129;
constexpr float NORM_EPS = 1e-6f;
constexpr float LAM_INIT = 0.2f;
constexpr float C2 = 0.125f * 1.4426950408889634f;

namespace pg8 {
template <bool SKIP = false> struct EpiInProjT {
    static constexpr bool PERM = true; static constexpr int WSCALE = 0x7f7f7f7f;
    bf16_t *Q, *Kb, *V, *U, *CB; const float* rcos; const float* rsin;
    unsigned* kmax;
    __device__ __forceinline__ void operator()(const f32x4 (&acc)[2][2][4][2], const Unit& u_in, int wr, int wc, int fr_, int fq_) const {
        const int l_ = hw_lane(), fr = l_ & 15, fq = l_ >> 4; (void)fr_; (void)fq_;
        const Unit& u = u_in;
        const int row0 = u.pm * BM + wr * 64 + fr; const int pn = u.pn;
        const bool xt = u.pm < RX / BM;
        if (pn < 4) {
            const int sh = (pn & 1) * 4 + wc;
            const float* rc0 = rcos + (xt ? NMETA + (u.pm & 31) * 256 + wr * 64 + fr : fr) * 32 + 8 * fq; const float* rs0 = rc0 + (rsin - rcos);
            const float sc = pn < 2 ? C2 : 1.0f;
            bf16_t* p0; int st_ai, st_m;
            if (pn < 2) { p0 = Q + (size_t)row0 * AW + sh * 64 + 8 * fq; st_ai = HALF * AW; st_m = 16 * AW; }
            else if (xt) { p0 = Kb + ((size_t)(((u.pm >> 5) * 8 + sh) * KV_TILES + 1 + (u.pm & 31) * 4 + wr)) * 4096 + fq * 512 + (16 * (fr >> 2) + 4 * ((fr >> 1) & 1) + 8 * (fr & 1)) * 8; st_ai = 2 * 4096; st_m = 8; }
            else { p0 = Kb + ((size_t)((wr * 4 * 8 + sh) * KV_TILES)) * 4096 + fq * 512 + fr * 8; st_ai = 0; st_m = 8 * KV_TILES * 4096; }
            const int o2 = pn < 2 ? 32 : 2048;
            f32x4 cb0 = *(const f32x4*)rc0, cb1 = *(const f32x4*)(rc0 + 4), sb0 = *(const f32x4*)rs0, sb1 = *(const f32x4*)(rs0 + 4);
            f32x4 cA0 = (f32x4){1.f, 1.f, 1.f, 1.f}, cA1 = cA0, sA0 = (f32x4){0.f, 0.f, 0.f, 0.f}, sA1 = sA0;
            if (xt) { cA0 = *(const f32x4*)(rcos + 16 * 32 + 8 * fq); cA1 = *(const f32x4*)(rcos + 16 * 32 + 8 * fq + 4); sA0 = *(const f32x4*)(rsin + 16 * 32 + 8 * fq); sA1 = *(const f32x4*)(rsin + 16 * 32 + 8 * fq + 4); }
            float ksq = 0.f;
#pragma unroll
            for (int ai = 0; ai < 2; ++ai) {
                if (!xt && ai == 1 && pn >= 2) break;
                f32x4 c0 = cb0, c1 = cb1, s0 = sb0, s1 = sb1;
#pragma unroll
                for (int m = 0; m < 4; ++m) {
                    const f32x4 x10 = acc[ai][0][m][0], x11 = acc[ai][0][m][1], x20 = acc[ai][1][m][0], x21 = acc[ai][1][m][1];
                    const f32x4 a0 = (x10 * c0 - x20 * s0) * sc, a1 = (x11 * c1 - x21 * s1) * sc, b0 = (x20 * c0 + x10 * s0) * sc, b1 = (x21 * c1 + x11 * s1) * sc;
                    bf16_t* p = p0 + (size_t)ai * st_ai + (size_t)m * st_m;
                    *(u32x4*)p = pack8(a0, a1); *(u32x4*)(p + o2) = pack8(b0, b1);
                    if (pn >= 2) { const f32x4 q_ = a0 * a0 + a1 * a1 + b0 * b0 + b1 * b1; float ps_ = (q_[0] + q_[1]) + (q_[2] + q_[3]);
                        ps_ += __shfl_xor(ps_, 16); ps_ += __shfl_xor(ps_, 32); ksq = fmaxf(ksq, ps_); }
                    if (m < 3) { const f32x4 n0 = c0 * cA0 - s0 * sA0, n1 = c1 * cA1 - s1 * sA1; s0 = s0 * cA0 + c0 * sA0; s1 = s1 * cA1 + c1 * sA1; c0 = n0; c1 = n1; } }
                if (ai == 0 && xt) { const f32x4 cB0 = *(const f32x4*)(rcos + 128 * 32 + 8 * fq), cB1 = *(const f32x4*)(rcos + 128 * 32 + 8 * fq + 4), sB0 = *(const f32x4*)(rsin + 128 * 32 + 8 * fq), sB1 = *(const f32x4*)(rsin + 128 * 32 + 8 * fq + 4);
                    const f32x4 n0 = cb0 * cB0 - sb0 * sB0, n1 = cb1 * cB1 - sb1 * sB1; sb0 = sb0 * cB0 + cb0 * sB0; sb1 = sb1 * cB1 + cb1 * sB1; cb0 = n0; cb1 = n1; }
            }
            if (pn >= 2 && xt) {
#pragma unroll
                for (int m_ = 1; m_ < 16; m_ <<= 1) ksq = fmaxf(ksq, __shfl_xor(ksq, m_));
                if (l_ == 0) { const unsigned old_ = __hip_atomic_fetch_max(kmax + (u.pm >> 5) * 8 + sh, __float_as_uint(ksq * 1.02f), __ATOMIC_RELAXED, __HIP_MEMORY_SCOPE_AGENT); asm volatile("" :: "v"(old_)); } }
        } else if (pn < 6) {
            if (xt) {
                unsigned char* p0 = (unsigned char*)V + ((size_t)(((u.pm >> 5) * 4 + (pn - 4) * 2) * KV_TILES + 1 + (u.pm & 31) * 4 + wr)) * 8192 + wc * 2048
                                    + ((fr >> 1) & 1) * 1024 + (fr >> 3) * 512 + fq * 128 + (2 * ((fr >> 2) & 1) + (fr & 1)) * 4;
#pragma unroll
                for (int ai = 0; ai < 2; ++ai)
#pragma unroll
                    for (int bj = 0; bj < 2; ++bj)
#pragma unroll
                        for (int n = 0; n < 2; ++n)
#pragma unroll
                            for (int i = 0; i < 4; ++i) { int w_ = __builtin_amdgcn_cvt_pk_fp8_f32(16.f * acc[ai][bj][0][n][i], 16.f * acc[ai][bj][1][n][i], 0, false);
                                w_ = __builtin_amdgcn_cvt_pk_fp8_f32(16.f * acc[ai][bj][2][n][i], 16.f * acc[ai][bj][3][n][i], w_, true);
                                *(int*)(p0 + (size_t)ai * (2 * 8192) + (size_t)bj * KV_TILES * 8192 + (4 * n + i) * 16) = w_; }
            }
        } else if (pn < 10) {
            const int colb = (pn - 6) * 128 + wc * 32 + 8 * fq;
#pragma unroll
            for (int ai = 0; ai < 2; ++ai)
#pragma unroll
                for (int m = 0; m < 4; ++m) { bf16_t* p = U + (size_t)(row0 + ai * HALF + m * 16) * CWID + colb;
                    *(u32x4*)p = pack8(acc[ai][0][m][0] * acc[ai][1][m][0], acc[ai][0][m][1] * acc[ai][1][m][1]); }
        } else {
            const int colb = (pn - 10) * 256 + wc * 32 + 8 * fq;
#pragma unroll
            for (int ai = 0; ai < 2; ++ai)
#pragma unroll
                for (int m = 0; m < 4; ++m) { bf16_t* p = CB + (size_t)(row0 + ai * HALF + m * 16) * CWID + colb;
#pragma unroll
                    for (int bj = 0; bj < 2; ++bj) *(u32x4*)(p + bj * HALF) = pack8(acc[ai][bj][m][0], acc[ai][bj][m][1]); }
        }
    }
};
typedef EpiInProjT<false> EpiInProj;
struct EpiOutProj {
    static constexpr bool PERM = true; static constexpr int WSCALE = 0x7f7f7f7f;
    const float* x; const float* meta; bf16_t* h1b; float* h1meta;
    __device__ __forceinline__ void operator()(const f32x4 (&acc)[2][2][4][2], const Unit& u, int wr, int wc, int fr, int fq) const {
        const int col0 = u.pn * BM + wc * 32 + 8 * fq;
        if (u.pm < RX / BM) {
#pragma unroll
            for (int ai = 0; ai < 2; ++ai)
#pragma unroll
                for (int m = 0; m < 4; ++m) { const size_t off = (size_t)(u.pm * BM + ai * HALF + wr * 64 + m * 16 + fr) * D + col0;
#pragma unroll
                    for (int bj = 0; bj < 2; ++bj) { const f32x4 b0 = *(const f32x4*)(x + off + bj * HALF), b1 = *(const f32x4*)(x + off + bj * HALF + 4);
                        *(u32x4*)(h1b + off + bj * HALF) = pack8(b0 + acc[ai][bj][m][0], b1 + acc[ai][bj][m][1]); } }
        } else {
#pragma unroll
            for (int m = 0; m < 4; ++m) { const int rr = wr * 64 + m * 16 + fr; const size_t off = (size_t)rr * D + col0; const size_t moff = (size_t)(rr & (NMETA - 1)) * D + col0;
#pragma unroll
                for (int bj = 0; bj < 2; ++bj)
#pragma unroll
                    for (int n = 0; n < 2; ++n) { const f32x4 bs = *(const f32x4*)(meta + moff + bj * HALF + n * 4); *(f32x4*)(h1meta + off + bj * HALF + n * 4) = bs + acc[0][bj][m][n]; } }
        }
    }
};
__device__ __forceinline__ unsigned pack4_fp8(const f32x4 v) { int w = __builtin_amdgcn_cvt_pk_fp8_f32(v[0], v[1], 0, false); w = __builtin_amdgcn_cvt_pk_fp8_f32(v[2], v[3], w, true); return (unsigned)w; }
struct EpiSwiglu {
    static constexpr bool PERM = true; static constexpr int WSCALE = 0x79797979;
    unsigned char* H;
    __device__ __forceinline__ void operator()(const f32x4 (&acc)[2][2][4][2], const Unit& u, int wr, int wc, int fr, int fq) const {
        typedef unsigned u32x2 __attribute__((ext_vector_type(2)));
        const int colb = (u.pn & 15) * 128 + wc * 32 + 8 * fq;
#pragma unroll
        for (int ai = 0; ai < 2; ++ai)
#pragma unroll
            for (int m = 0; m < 4; ++m) { f32x4 h[2];
#pragma unroll
                for (int n = 0; n < 2; ++n) { const f32x4 a = acc[ai][0][m][n], b = acc[ai][1][m][n];
#pragma unroll
                    for (int i = 0; i < 4; ++i) h[n][i] = a[i] * __builtin_amdgcn_rcpf(1.0f + __builtin_amdgcn_exp2f(-1.4426950408889634f * a[i])) * b[i]; }
                *(u32x2*)(H + (size_t)(u.pm * BM + ai * HALF + wr * 64 + m * 16 + fr) * FF + colb) = (u32x2){pack4_fp8(h[0]), pack4_fp8(h[1])}; }
    }
};
struct EpiDown {
    static constexpr bool PERM = true; static constexpr int WSCALE = 0x79797979;
    unsigned char* Y; const float* gate;
    __device__ __forceinline__ void operator()(const f32x4 (&acc)[2][2][4][2], const Unit& u, int wr, int wc, int fr, int fq) const {
        typedef unsigned u32x2 __attribute__((ext_vector_type(2)));
        const int colb = (u.pn & 3) * 256 + wc * 32 + 8 * fq;
#pragma unroll
        for (int ai = 0; ai < 2; ++ai)
#pragma unroll
            for (int m = 0; m < 4; ++m) { const int r = u.pm * BM + ai * HALF + wr * 64 + m * 16 + fr; const float gv = gate[r] * 16.0f;
#pragma unroll
                for (int bj = 0; bj < 2; ++bj) *(u32x2*)(Y + (size_t)r * D + colb + bj * HALF) = (u32x2){pack4_fp8(acc[ai][bj][m][0] * gv), pack4_fp8(acc[ai][bj][m][1] * gv)}; }
    }
};
}
namespace pg8 {
struct ThinAcc { f32x4 v[2]; };
template <bool FP8, class RowF>
__device__ __forceinline__ void thin_gemm(const unsigned char* A, const unsigned char* Bt, int Kb  , int pn_flat, const RowF& rowf, int wid, int lane, ThinAcc& T, int wscale) {
    const int fr = lane & 15, kq = lane >> 4, wc = wid & 3, n = wid >> 2;
    const unsigned char* ap = A + (size_t)rowf(fr) * Kb;
    const int bcol = 32 * wc + 8 * (fr >> 2) + 4 * n + (fr & 3);
    const unsigned char* bp0 = Bt + ((size_t)pn_flat * BM + bcol) * Kb, * bp1 = bp0 + (size_t)HALF * Kb;
    T.v[0] = (f32x4){0.f, 0.f, 0.f, 0.f}; T.v[1] = T.v[0];
    if constexpr (FP8) {
        const int ascale = 0x7f7f7f7f;
#pragma unroll 4
        for (int s = 0; s < Kb / 128; ++s) { const int o = s * 128 + kq * 32;
            const v4i_t a0 = *(const v4i_t*)(ap + o), a1 = *(const v4i_t*)(ap + o + 16), b00 = *(const v4i_t*)(bp0 + o), b01 = *(const v4i_t*)(bp0 + o + 16), b10 = *(const v4i_t*)(bp1 + o), b11 = *(const v4i_t*)(bp1 + o + 16);
            const v8i_t a8 = __builtin_shufflevector(a0, a1, 0, 1, 2, 3, 4, 5, 6, 7), b08 = __builtin_shufflevector(b00, b01, 0, 1, 2, 3, 4, 5, 6, 7), b18 = __builtin_shufflevector(b10, b11, 0, 1, 2, 3, 4, 5, 6, 7);
            T.v[0] = __builtin_amdgcn_mfma_scale_f32_16x16x128_f8f6f4(b08, a8, T.v[0], 0, 0, 0, wscale, 0, ascale);
            T.v[1] = __builtin_amdgcn_mfma_scale_f32_16x16x128_f8f6f4(b18, a8, T.v[1], 0, 0, 0, wscale, 0, ascale); }
    } else {
#pragma unroll 8
        for (int s = 0; s < Kb / 64; ++s) { const int o = s * 64 + kq * 16;
            const bf16x8 a = *(const bf16x8*)(ap + o), b0 = *(const bf16x8*)(bp0 + o), b1 = *(const bf16x8*)(bp1 + o);
            T.v[0] = __builtin_amdgcn_mfma_f32_16x16x32_bf16(b0, a, T.v[0], 0, 0, 0);
            T.v[1] = __builtin_amdgcn_mfma_f32_16x16x32_bf16(b1, a, T.v[1], 0, 0, 0); }
    }
}
typedef unsigned u32x2 __attribute__((ext_vector_type(2)));
__device__ __forceinline__ u32x2 pack4(const f32x4 v) { return (u32x2){cvt_pk_bf16(v[0], v[1]), cvt_pk_bf16(v[2], v[3])}; }
__device__ __forceinline__ void thin_epi_inproj(const ThinAcc& T, int pn, int wid, int lane, bf16_t* Q, bf16_t* Kb, bf16_t* V, bf16_t* U, bf16_t* CB, const float* rcos, const float* rsin, unsigned* kmax) {
    const int fr = lane & 15, fq = lane >> 4, wc = wid & 3, n = wid >> 2, c8 = 8 * fq + 4 * n;
    if (pn < 4) {
        const int sh = (pn & 1) * 4 + wc; const float sc = pn < 2 ? C2 : 1.0f;
        const f32x4 c = *(const f32x4*)(rcos + fr * 32 + c8), s = *(const f32x4*)(rsin + fr * 32 + c8);
        const f32x4 r1 = (T.v[0] * c - T.v[1] * s) * sc, r2 = (T.v[1] * c + T.v[0] * s) * sc;
        const u32x2 o1 = pack4(r1), o2 = pack4(r2);
        if (pn >= 2) {
            const f32x4 q_ = r1 * r1 + r2 * r2; float ps_ = (q_[0] + q_[1]) + (q_[2] + q_[3]); ps_ += __shfl_xor(ps_, 16); ps_ += __shfl_xor(ps_, 32);
#pragma unroll
            for (int m_ = 1; m_ < 16; m_ <<= 1) ps_ = fmaxf(ps_, __shfl_xor(ps_, m_));
            if (lane == 0) for (int b = 0; b < BATCH; ++b) { const unsigned old_ = __hip_atomic_fetch_max(kmax + b * 8 + sh, __float_as_uint(ps_ * 2.04f), __ATOMIC_RELAXED, __HIP_MEMORY_SCOPE_AGENT); asm volatile("" :: "v"(old_)); } }
        for (int b = 0; b < BATCH; ++b) {
            if (pn < 2) { bf16_t* p = Q + (size_t)(RX + NMETA * b + fr) * AW + sh * 64 + c8; *(u32x2*)p = o1; *(u32x2*)(p + 32) = o2; }
            else { bf16_t* p = Kb + ((size_t)((b * 8 + sh) * KV_TILES)) * 4096 + fq * 512 + fr * 8 + 4 * n; *(u32x2*)p = o1; *(u32x2*)(p + 2048) = o2; } }
    } else if (pn < 6) {
        for (int b = 0; b < BATCH; ++b)
#pragma unroll
            for (int bj = 0; bj < 2; ++bj) {
                const unsigned w = pack4_fp8(T.v[bj] * 16.0f);
                unsigned char* p = (unsigned char*)V + ((size_t)((b * 4 + (pn - 4) * 2 + bj) * KV_TILES)) * 8192 + wc * 2048 + ((fr >> 2) & 1) * 1024 + c8 * 16 + (fr >> 3) * 4 + (fr & 3);
                p[0] = (unsigned char)(w & 0xffu); p[16] = (unsigned char)((w >> 8) & 0xffu); p[32] = (unsigned char)((w >> 16) & 0xffu); p[48] = (unsigned char)(w >> 24); }
    } else if (pn < 10) {
        const u32x2 o = pack4(T.v[0] * T.v[1]);
        for (int b = 0; b < BATCH; ++b) *(u32x2*)(U + (size_t)(RX + NMETA * b + fr) * CWID + (pn - 6) * 128 + wc * 32 + c8) = o;
    } else {
        for (int b = 0; b < BATCH; ++b)
#pragma unroll
            for (int bj = 0; bj < 2; ++bj) *(u32x2*)(CB + (size_t)(RX + NMETA * b + fr) * CWID + (pn - 10) * 256 + bj * HALF + wc * 32 + c8) = pack4(T.v[bj]);
    }
}
__device__ __forceinline__ void thin_epi_outproj(const ThinAcc& T, int b, int pn, int wid, int lane, const float* meta, float* h1meta) {
    const int fr = lane & 15, fq = lane >> 4, wc = wid & 3, n = wid >> 2;
#pragma unroll
    for (int bj = 0; bj < 2; ++bj) { const int col = pn * BM + bj * HALF + wc * 32 + 8 * fq + 4 * n;
        *(f32x4*)(h1meta + (size_t)(NMETA * b + fr) * D + col) = *(const f32x4*)(meta + (size_t)fr * D + col) + T.v[bj]; }
}
__device__ __forceinline__ void thin_epi_swiglu(const ThinAcc& T, int e, int ct, int wid, int lane, unsigned char* H) {
    const int fr = lane & 15, fq = lane >> 4, wc = wid & 3, n = wid >> 2; f32x4 h;
#pragma unroll
    for (int i = 0; i < 4; ++i) { const float a = T.v[0][i]; h[i] = a * __builtin_amdgcn_rcpf(1.0f + __builtin_amdgcn_exp2f(-1.4426950408889634f * a)) * T.v[1][i]; }
    *(unsigned*)(H + (size_t)(e * EPAD + 32 * BM + fr) * FF + ct * 128 + wc * 32 + 8 * fq + 4 * n) = pack4_fp8(h);
}
__device__ __forceinline__ void thin_epi_down(const ThinAcc& T, int e, int ct, int wid, int lane, unsigned char* Y, const float* gate) {
    const int fr = lane & 15, fq = lane >> 4, wc = wid & 3, n = wid >> 2; const int r = e * EPAD + 32 * BM + fr; const float gv = gate[r] * 16.0f;
#pragma unroll
    for (int bj = 0; bj < 2; ++bj) *(unsigned*)(Y + (size_t)r * D + ct * 256 + bj * HALF + wc * 32 + 8 * fq + 4 * n) = pack4_fp8(T.v[bj] * gv);
}
}
constexpr size_t al256(size_t x) { return (x + 255) & ~(size_t)255; }
constexpr size_t WS_CTL = 0, CTL_ZERO_BYTES = 65536;
constexpr size_t WS_ROPE = WS_CTL + CTL_ZERO_BYTES;
constexpr size_t SZ_ROPE = al256((size_t)LSEQ * 32 * 4 * 2);
constexpr size_t WS_AFF = WS_ROPE + SZ_ROPE;
constexpr size_t SZ_AFF = al256((size_t)BATCH * NEXP * LSEQ * 4);
constexpr size_t WS_IDX = WS_AFF + SZ_AFF;
constexpr size_t SZ_IDX = al256((size_t)NEXP * EPAD * 4);
constexpr size_t WS_GATE = WS_IDX + SZ_IDX;
constexpr size_t WS_INV = WS_GATE + SZ_IDX;
constexpr size_t SZ_INV = al256((size_t)RV * NEXP * 4);
constexpr size_t WS_PART = WS_INV + SZ_INV;
constexpr size_t SZ_PART = al256((size_t)32 * 7 * 2 * (64 + 4 * 8 * 64) * 4);
constexpr size_t WS_RTAB = WS_PART + SZ_PART;
constexpr size_t SZ_RTAB = al256((size_t)2 * 16 * 1032 * 2 + 1024 * 4);
constexpr size_t WS_H1M = WS_RTAB + SZ_RTAB;
constexpr size_t SZ_H1M = (size_t)BATCH * NMETA * D * 4;
constexpr size_t WS_WIN = al256(WS_H1M + SZ_H1M);
constexpr size_t SZ_WIN = (size_t)NPROJ * D * 2;
constexpr size_t WS_WOUT = WS_WIN + SZ_WIN;
constexpr size_t SZ_WOUT = (size_t)D * D * 2;
constexpr size_t WS_Q = WS_WOUT + SZ_WOUT;
constexpr size_t SZ_QKV = (size_t)RP * AW * 2;
constexpr size_t SZ_KIMG = (size_t)BATCH * 8 * KV_TILES * 8192;
constexpr size_t WS_K = WS_Q + SZ_QKV;
constexpr size_t WS_W1 = WS_K + SZ_KIMG;
constexpr size_t SZ_W1 = (size_t)NEXP * 2 * FF * D * 2;
constexpr size_t WS_Y = WS_WIN;
constexpr size_t SZ_Y = (size_t)NEXP * EPAD * D * 2;
static_assert(WS_W1 + SZ_W1 - WS_Y >= SZ_Y, "Y overlay fits");
constexpr size_t WS_W2 = WS_W1 + SZ_W1;
constexpr size_t SZ_W2 = (size_t)NEXP * D * FF * 2;
constexpr size_t WS_XN = WS_W2 + SZ_W2;
constexpr size_t SZ_XN = (size_t)RP * D * 2;
constexpr size_t WS_V = WS_XN + SZ_XN, WS_U = WS_V + SZ_KIMG, WS_CB = WS_U + SZ_QKV;
constexpr size_t WS_H = WS_XN;
constexpr size_t SZ_H = (size_t)NEXP * EPAD * FF * 2;
constexpr size_t SZ_H8 = (size_t)NEXP * EPAD * FF;
constexpr size_t WS_H1B = WS_H + SZ_H8;
constexpr size_t WS_HN2 = WS_H1B + (size_t)RX * D * 2;
constexpr size_t WS_END = WS_H + SZ_H;
static_assert(WS_HN2 + (size_t)RP * D <= WS_END, "H | H1B | HN2 fit in the H region");
static_assert(WS_CB + SZ_QKV <= WS_END, "H region covers XN, V, U, CB");
static_assert(WS_END <= (size_t)1 << 30, "workspace map fits in 1 GiB");
constexpr int CW_BAR = 1024;
constexpr int CW_KMAX = 8192;

constexpr int RING_OFF = 0, RING_BYTES = 131072;
constexpr int LDS_BYTES = 163840;
constexpr int MISC_OFF = LDS_BYTES - 256;

#define GAS __attribute__((address_space(1)))
#define LAS __attribute__((address_space(3)))
typedef unsigned short bf16;
typedef unsigned v4u __attribute__((ext_vector_type(4)));
typedef unsigned v2u __attribute__((ext_vector_type(2)));
typedef float f32x4 __attribute__((ext_vector_type(4)));
#define LDS_WAIT() asm volatile("s_waitcnt lgkmcnt(0)" ::: "memory")
#define VM_WAIT() asm volatile("s_waitcnt vmcnt(0)" ::: "memory")
__device__ __forceinline__ unsigned pk2(float lo, float hi) { return pg8::cvt_pk_bf16(lo, hi); }
__device__ __forceinline__ float bf_lo(unsigned w) { return __uint_as_float(w << 16); }
__device__ __forceinline__ float bf_hi(unsigned w) { return __uint_as_float(w & 0xffff0000u); }
__device__ __forceinline__ float wave_sum(float v) {
#pragma unroll
    for (int o = 1; o < 64; o <<= 1) v += __shfl_xor(v, o);
    return v;
}
namespace att {
#define ALAS __attribute__((address_space(3)))
typedef unsigned short bf16_t;
typedef short bf16x8 __attribute__((ext_vector_type(8)));
typedef short s16x4 __attribute__((ext_vector_type(4)));
typedef float f32x16 __attribute__((ext_vector_type(16)));
typedef unsigned u32x4 __attribute__((ext_vector_type(4)));
typedef int i32x4 __attribute__((ext_vector_type(4)));
typedef int i32x8 __attribute__((ext_vector_type(8)));
constexpr int KT = 64, NTILE = 129, SLOT = 16384;
constexpr int OFF_K = 0, OFF_V = 3 * SLOT, OFF_WS = 6 * SLOT, LDS_BYTES = OFF_WS + 8 * 256;
__device__ __forceinline__ int crow(int r, int hi) { return (r & 3) + 8 * (r >> 2) + 4 * hi; }
__device__ __forceinline__ unsigned cvtpk(float lo, float hi) { typedef float f32x2_t __attribute__((ext_vector_type(2))); typedef __bf16 bf16x2_t __attribute__((ext_vector_type(2)));
    f32x2_t v = {lo, hi}; bf16x2_t b = __builtin_convertvector(v, bf16x2_t); return __builtin_bit_cast(unsigned, b); }
__device__ __forceinline__ s16x4 vtr(const ALAS char* p) { typedef short v4i16_t __attribute__((ext_vector_type(4))); return __builtin_bit_cast(s16x4, __builtin_amdgcn_ds_read_tr16_b64_v4i16((ALAS v4i16_t*)p)); }
__device__ __forceinline__ float swapmax(float m) { auto rr = __builtin_amdgcn_permlane32_swap(__float_as_uint(m), __float_as_uint(m), false, false); return __builtin_fmaxf(__uint_as_float(rr[0]), __uint_as_float(rr[1])); }
__device__ __forceinline__ float swapsum(float m) { auto rr = __builtin_amdgcn_permlane32_swap(__float_as_uint(m), __float_as_uint(m), false, false); return __uint_as_float(rr[0]) + __uint_as_float(rr[1]); }
__device__ __forceinline__ void glds_k4(const void* sbase, unsigned voff, unsigned lds_dst) { unsigned keep;
    asm volatile("s_mov_b32 %0, m0\n\ts_mov_b32 m0, %3\n\ts_nop 0\n\tglobal_load_lds_dwordx4 %1, %2\n\tglobal_load_lds_dwordx4 %1, %2 offset:1024\n\tglobal_load_lds_dwordx4 %1, %2 offset:2048\n\tglobal_load_lds_dwordx4 %1, %2 offset:3072\n\ts_mov_b32 m0, %0"
                 : "=&s"(keep) : "v"(voff), "s"(sbase), "s"(lds_dst) : "memory"); }
__device__ __forceinline__ void glds_v2(const void* sbase, unsigned voff, unsigned lds_dst) { unsigned keep;
    asm volatile("s_mov_b32 %0, m0\n\ts_mov_b32 m0, %3\n\ts_nop 0\n\tglobal_load_lds_dwordx4 %1, %2\n\tglobal_load_lds_dwordx4 %1, %2 offset:1024\n\ts_mov_b32 m0, %0" : "=&s"(keep) : "v"(voff), "s"(sbase), "s"(lds_dst) : "memory"); }
#define WAITBAR(last) do { if (last) asm volatile("s_waitcnt vmcnt(0) lgkmcnt(0)\n\ts_barrier" ::: "memory"); else if (kwave) asm volatile("s_waitcnt vmcnt(4) lgkmcnt(0)\n\ts_barrier" ::: "memory"); \
        else asm volatile("s_waitcnt vmcnt(2) lgkmcnt(0)\n\ts_barrier" ::: "memory"); } while (0)
#define MX3(a, b, c) __builtin_fmaxf(__builtin_fmaxf((a), (b)), (c))
#define SBAR() __builtin_amdgcn_sched_barrier(0)
#define PIN(x) asm volatile("" : "+v"(x))
#define EX(v) ((MODE & 2) ? (v) * 0.5f : __builtin_amdgcn_exp2f(v))

struct Tensors { const bf16_t *Q, *K, *V; bf16_t* MIX; const float* subg; float lam; const float* kmax; };
constexpr int PART_F32 = 64 + 4 * 8 * 64;
constexpr int META_CHUNKS = 7;
__device__ __forceinline__ void meta_chunk(int c, int& tb, int& te) { tb = c < 5 ? 19 * c : 95 + 17 * (c - 5); te = tb + (c < 5 ? 19 : 17); }


template <int THRL, int MODE = 0>
__device__ __forceinline__ void attn_unit(const Tensors& T, int b, int h, int qrow0, int nvalid, int tb, int te, float* part, ALAS char* shm, const int wid) {
    const int lane = hw_lane(), r32 = lane & 31, hi = lane >> 5;
    const int sub = wid & 1, rg = wid >> 1, rgq = part ? 0 : rg;
    ALAS float* wsf = (ALAS float*)(shm + OFF_WS) + wid * 64;
    const unsigned lds0 = (unsigned)(uintptr_t)shm;
    const bool kwave = wid < 4;
    const char* gsrc = kwave ? (const char*)T.K + ((size_t)((b * 8 + h * 2 + (wid >> 1)) * NTILE)) * 8192 + (wid & 1) * 4096
                             : (const char*)T.V + ((size_t)((b * 4 + h) * NTILE)) * 8192 + (wid - 4) * 2048;
    const int tstride = 8192;
    const unsigned ldst = lds0 + (kwave ? (unsigned)(OFF_K + wid * 4096) : (unsigned)(OFF_V + (wid - 4) * 2048));
    const unsigned lane16 = (unsigned)lane * 16u;
#define ATT_ISSUE(tt, so) do { const char* sb_ = gsrc + (size_t)(tt) * tstride; const unsigned d_ = ldst + (unsigned)(so); \
        if (kwave) glds_k4(sb_, lane16, d_); else glds_v2(sb_, lane16, d_); } while (0)
    if (kwave) { ATT_ISSUE(tb, 0); ATT_ISSUE(tb + 1, SLOT); } else { ATT_ISSUE(tb, 0); }
    bf16x8 qr[4];
    { const bf16_t* qp = T.Q + (size_t)(qrow0 + rgq * 32 + (part ? (r32 & 15) : r32)) * AW + h * 128 + sub * 64 + hi * 8;
#pragma unroll
      for (int d0 = 0; d0 < 4; ++d0) qr[d0] = *(const bf16x8*)(qp + d0 * 16); }
    asm volatile("" : "+v"(qr[0]), "+v"(qr[1]), "+v"(qr[2]), "+v"(qr[3]));
    f32x16 o[4];
#pragma unroll
    for (int d = 0; d < 4; ++d) o[d] = f32x16{};
    float mref = 0.f;
    f32x16 negm = f32x16{}; PIN(negm);
    int sclA = 0x7f7f7f7f, sclB = 0x7b7b7b7b; PIN(sclA); PIN(sclB);
    float l_reg = 0.f;
    const ALAS char* kp0 = (const ALAS char*)shm + OFF_K + sub * 8192 + hi * 1024 + r32 * 16;
    const ALAS char* vp0 = (const ALAS char*)shm + OFF_V + hi * 1024 + r32 * 16;
    f32x16 pA0, pA1, pB0, pB1; i32x8 pa = i32x8{};
    bf16x8 kf[4]; i32x8 vfa, vfb;
    WAITBAR(false);
    if (kwave) { ATT_ISSUE(tb + 2, 2 * SLOT); } else { ATT_ISSUE(tb + 1, SLOT); }
    {
#pragma unroll
        for (int d0 = 0; d0 < 4; ++d0) { const bf16x8 k0 = *(const ALAS bf16x8*)(kp0 + d0 * 2048), k1 = *(const ALAS bf16x8*)(kp0 + d0 * 2048 + 512);
            if (d0 == 0) { pA0 = __builtin_amdgcn_mfma_f32_32x32x16_bf16(k0, qr[0], negm, 0, 0, 0); pA1 = __builtin_amdgcn_mfma_f32_32x32x16_bf16(k1, qr[0], negm, 0, 0, 0); }
            else { pA0 = __builtin_amdgcn_mfma_f32_32x32x16_bf16(k0, qr[d0], pA0, 0, 0, 0); pA1 = __builtin_amdgcn_mfma_f32_32x32x16_bf16(k1, qr[d0], pA1, 0, 0, 0); } }
        if (tb == 0) {
#pragma unroll
            for (int r = 8; r < 16; ++r) pA0[r] = -INFINITY;
#pragma unroll
            for (int r = 0; r < 16; ++r) pA1[r] = -INFINITY;
        }
        float rm = __builtin_fmaxf(pA0[0], pA1[0]);
#pragma unroll
        for (int r = 1; r < 16; ++r) rm = __builtin_fmaxf(rm, __builtin_fmaxf(pA0[r], pA1[r]));
        rm = swapmax(rm);
        mref = rm - 2.0f;
#pragma unroll
        for (int r = 0; r < 16; ++r) { pA0[r] = EX(pA0[r] - mref); pA1[r] = EX(pA1[r] - mref); }
#pragma unroll
        for (int r = 0; r < 16; ++r) negm[r] = -mref;
        PIN(negm);
    }
    WAITBAR(false);
    int ks_cur = SLOT, ks_nx2 = 0;
    int vs_prv = 0, vs_nx1 = 2 * SLOT;
#define PK4(P, B, OLD) __builtin_amdgcn_cvt_pk_fp8_f32(P[(B) + 2], P[(B) + 3], __builtin_amdgcn_cvt_pk_fp8_f32(P[B], P[(B) + 1], OLD, false), true)
#define KRD(j) (*(const ALAS bf16x8*)(kp_ + ((j) >> 1) * 2048 + ((j) & 1) * 512))
#define VLD(d) __builtin_shufflevector(*(const ALAS i32x4*)(vp_ + (d) * 2048), *(const ALAS i32x4*)(vp_ + (d) * 2048 + 512), 0, 1, 2, 3, 4, 5, 6, 7)
#define PVMFMA(acc, B) asm volatile("v_mfma_scale_f32_32x32x64_f8f6f4 %0, %1, %2, %0, %3, %4 op_sel_hi:[0,0,0]" : "+v"(acc) : "v"(pa), "v"(B), "v"(sclA), "v"(sclB))
#define RECENTER(P0, P1) \
        float pm_ = MX3(P0[0], P0[1], P1[0]), pq_ = MX3(P0[2], P0[3], P1[1]); pm_ = MX3(pm_, P1[2], P1[3]); \
        _Pragma("unroll") for (int r = 4; r < 16; r += 4) { pm_ = MX3(pm_, P0[r], P0[r + 1]); pq_ = MX3(pq_, P0[r + 2], P0[r + 3]); pm_ = MX3(pm_, P1[r], P1[r + 1]); pq_ = MX3(pq_, P1[r + 2], P1[r + 3]); } \
        pm_ = swapmax(__builtin_fminf(__builtin_fmaxf(pm_, pq_), 3.0e38f)); \
        const float dl_ = __builtin_fmaxf(__builtin_amdgcn_logf(pm_) - 2.0f, 0.f), f_ = __builtin_amdgcn_exp2f(-dl_); \
        mref += dl_; sacc = 0.f; \
        _Pragma("unroll") for (int r = 0; r < 16; ++r) { P0[r] = __builtin_fminf(P0[r], 3.0e38f) * f_; P1[r] = __builtin_fminf(P1[r], 3.0e38f) * f_; sacc += P0[r] + P1[r]; } \
        pa[0] = PK4(P0, 0, pa[0]); pa[1] = PK4(P0, 4, pa[1]); pa[2] = PK4(P0, 8, pa[2]); pa[3] = PK4(P0, 12, pa[3]); \
        pa[4] = PK4(P1, 0, pa[4]); pa[5] = PK4(P1, 4, pa[5]); pa[6] = PK4(P1, 8, pa[6]); pa[7] = PK4(P1, 12, pa[7]); PIN(pa); \
        _Pragma("unroll") for (int r = 0; r < 16; ++r) negm[r] = -mref; PIN(negm); \
        l_reg *= f_; if (hi == 0) wsf[r32] = f_; \
        asm volatile("s_nop 15\n\ts_nop 15" ::: "memory"); _Pragma("unroll") for (int d = 0; d < 4; ++d) PIN(o[d]); \
        _Pragma("unroll") for (int r = 0; r < 16; ++r) { const float fr_ = wsf[crow(r, hi)]; _Pragma("unroll") for (int d = 0; d < 4; ++d) o[d][r] *= fr_; } \
        _Pragma("unroll") for (int d = 0; d < 4; ++d) PIN(o[d]); asm volatile("s_nop 7" ::: "memory");
#define FILLA(P0, P1, j) do { \
        if ((j) == 0) { sacc = P0[0] + P0[1]; sacc += P0[2]; sacc += P0[3]; pa[0] = PK4(P0, 0, pa[0]); } \
        if ((j) == 1) { sacc += P0[4]; sacc += P0[5]; sacc += P0[6]; sacc += P0[7]; pa[1] = PK4(P0, 4, pa[1]); } \
        if ((j) == 2) { sacc += P0[8]; sacc += P0[9]; sacc += P0[10]; sacc += P0[11]; pa[2] = PK4(P0, 8, pa[2]); } \
        if ((j) == 3) { sacc += P0[12]; sacc += P0[13]; sacc += P0[14]; sacc += P0[15]; pa[3] = PK4(P0, 12, pa[3]); } \
        if ((j) == 4) { sacc += P1[0]; sacc += P1[1]; sacc += P1[2]; sacc += P1[3]; pa[4] = PK4(P1, 0, pa[4]); } \
        if ((j) == 5) { sacc += P1[4]; sacc += P1[5]; sacc += P1[6]; sacc += P1[7]; pa[5] = PK4(P1, 4, pa[5]); } \
        if ((j) == 6) { sacc += P1[8]; sacc += P1[9]; sacc += P1[10]; sacc += P1[11]; pa[6] = PK4(P1, 8, pa[6]); } \
        if ((j) == 7) { sacc += P1[12]; sacc += P1[13]; sacc += P1[14]; sacc += P1[15]; pa[7] = PK4(P1, 12, pa[7]); } \
        } while (0)
#define GAPA(C0, C1, P0, P1, j) do { \
        if ((j) == 0) C0 = __builtin_amdgcn_mfma_f32_32x32x16_bf16(kf[0], qr[0], negm, 0, 0, 0); \
        else if ((j) == 1) C1 = __builtin_amdgcn_mfma_f32_32x32x16_bf16(kf[1], qr[0], negm, 0, 0, 0); \
        else if (((j) & 1) == 0) C0 = __builtin_amdgcn_mfma_f32_32x32x16_bf16(kf[(j) & 3], qr[(j) >> 1], C0, 0, 0, 0); \
        else C1 = __builtin_amdgcn_mfma_f32_32x32x16_bf16(kf[(j) & 3], qr[(j) >> 1], C1, 0, 0, 0); \
        if ((j) + 4 < 8) kf[(j) & 3] = KRD((j) + 4); \
        FILLA(P0, P1, j); SBAR(); } while (0)
#define GAPB(C0, C1, i) do { \
        if ((i) == 0) PVMFMA(o[0], vfa); if ((i) == 4) PVMFMA(o[1], vfb); if ((i) == 8) PVMFMA(o[2], vfa); if ((i) == 12) PVMFMA(o[3], vfb); \
        if ((i) == 1) vfa = VLD(2); if ((i) == 5) vfb = VLD(3); \
        if ((i) < 8) { C0[2 * (i)] = EX(C0[2 * (i)]); C0[2 * (i) + 1] = EX(C0[2 * (i) + 1]); } \
        else { C1[2 * (i) - 16] = EX(C1[2 * (i) - 16]); C1[2 * (i) - 15] = EX(C1[2 * (i) - 15]); } \
        SBAR(); } while (0)
#define STEP(C0, C1, P0, P1, t) do { SBAR(); asm volatile("" : "+s"(wsel)); const bool kw_ = wsel < 4; \
        const ALAS char* kp_ = kp0 + ks_cur; const ALAS char* vp_ = vp0 + vs_prv; \
        kf[0] = KRD(0); kf[1] = KRD(1); kf[2] = KRD(2); kf[3] = KRD(3); SBAR(); \
        if (kw_) { if ((t) + 2 < te) glds_k4(gnext, lane16, ldst + (unsigned)ks_nx2); } else { if ((t) + 1 < te) glds_v2(gnext, lane16, ldst + (unsigned)vs_nx1); } gnext += 8192; \
        SBAR(); float sacc; \
        GAPA(C0, C1, P0, P1, 0); GAPA(C0, C1, P0, P1, 1); GAPA(C0, C1, P0, P1, 2); GAPA(C0, C1, P0, P1, 3); \
        GAPA(C0, C1, P0, P1, 4); GAPA(C0, C1, P0, P1, 5); vfa = VLD(0); vfb = VLD(1); SBAR(); GAPA(C0, C1, P0, P1, 6); GAPA(C0, C1, P0, P1, 7); \
        if (__builtin_expect(__any(!(sacc <= 256.0f)), 0)) { RECENTER(P0, P1); \
            _Pragma("unroll") for (int r = 0; r < 16; ++r) { C0[r] -= dl_; C1[r] -= dl_; } } \
        l_reg += sacc; \
        SBAR(); if (!kw_) { if ((t) + 1 >= te) asm volatile("s_waitcnt vmcnt(0) lgkmcnt(0)\n\ts_barrier" ::: "memory"); else asm volatile("s_waitcnt vmcnt(2) lgkmcnt(0)\n\ts_barrier" ::: "memory"); } SBAR(); \
        GAPB(C0, C1, 0); GAPB(C0, C1, 1); GAPB(C0, C1, 2); GAPB(C0, C1, 3); GAPB(C0, C1, 4); GAPB(C0, C1, 5); GAPB(C0, C1, 6); GAPB(C0, C1, 7); \
        GAPB(C0, C1, 8); GAPB(C0, C1, 9); GAPB(C0, C1, 10); GAPB(C0, C1, 11); GAPB(C0, C1, 12); GAPB(C0, C1, 13); GAPB(C0, C1, 14); GAPB(C0, C1, 15); \
        PIN(C0); PIN(C1); SBAR(); \
        if (kw_) { if ((t) + 2 >= te) asm volatile("s_waitcnt vmcnt(0) lgkmcnt(0)\n\ts_barrier" ::: "memory"); else asm volatile("s_waitcnt vmcnt(4) lgkmcnt(0)\n\ts_barrier" ::: "memory"); } \
        { const int nk_ = ks_cur + SLOT; const int kn_ = nk_ == 3 * SLOT ? 0 : nk_; ks_nx2 = ks_cur; ks_cur = kn_; } \
        { const int nv_ = vs_prv + SLOT; const int vn_ = nv_ == 3 * SLOT ? 0 : nv_; vs_nx1 = vs_prv; vs_prv = vn_; } \
    } while (0)
    const char* gnext = gsrc + (size_t)(tb + (kwave ? 3 : 2)) * 8192;
    int wsel = wid;
    if (wid >= 4) __builtin_amdgcn_s_setprio(1);
#pragma unroll 1
    for (int t = tb + 1; t < te; t += 2) {
        STEP(pB0, pB1, pA0, pA1, t);
        STEP(pA0, pA1, pB0, pB1, t + 1);
    }
    __builtin_amdgcn_s_setprio(0);
    { float sacc = 0.f;
#pragma unroll
      for (int r = 0; r < 16; ++r) sacc += pA0[r] + pA1[r];
      if (__any(!(sacc <= 256.0f))) { RECENTER(pA0, pA1); (void)dl_; }
      l_reg += sacc;
      pa[0] = PK4(pA0, 0, pa[0]); pa[1] = PK4(pA0, 4, pa[1]); pa[2] = PK4(pA0, 8, pa[2]); pa[3] = PK4(pA0, 12, pa[3]); pa[4] = PK4(pA1, 0, pa[4]); pa[5] = PK4(pA1, 4, pa[5]); pa[6] = PK4(pA1, 8, pa[6]); pa[7] = PK4(pA1, 12, pa[7]); PIN(pa);
      const ALAS char* vp_ = vp0 + vs_prv;
      vfa = VLD(0); vfb = VLD(1); PVMFMA(o[0], vfa); PVMFMA(o[1], vfb); PIN(vfa); PIN(vfb); vfa = VLD(2); vfb = VLD(3); PVMFMA(o[2], vfa); PVMFMA(o[3], vfb);
      asm volatile("s_nop 15\n\ts_nop 15" ::: "memory");
#pragma unroll
      for (int d = 0; d < 4; ++d) PIN(o[d]); }
#undef ATT_ISSUE
#undef PK4
#undef KRD
#undef VLD
#undef PVMFMA
#undef FILLA
#undef RECENTER
#undef GAPA
#undef GAPB
#undef STEP
    if (part) {
        const float lp = swapsum(l_reg);
        if (rg == 0) { float* pp = part + (size_t)sub * PART_F32;
            if (hi == 0) { pp[r32] = mref; pp[32 + r32] = lp; }
#pragma unroll
            for (int d = 0; d < 4; ++d)
#pragma unroll
                for (int r = 0; r < 8; ++r) pp[64 + (d * 8 + r) * 64 + lane] = o[d][r]; }
        asm volatile("s_waitcnt lgkmcnt(0)\n\ts_barrier" ::: "memory");
        return;
    }
    float l = swapsum(l_reg);
    if (hi == 0) wsf[32 + r32] = l;
    float rli[16];
#pragma unroll
    for (int r = 0; r < 16; ++r) rli[r] = 1.0f / wsf[32 + crow(r, hi)];
    asm volatile("s_waitcnt lgkmcnt(0)\n\ts_barrier" ::: "memory");
    ALAS float* X = (ALAS float*)shm + (size_t)rg * 4096 + lane;
    if (sub == 1) {
#pragma unroll
        for (int d = 0; d < 4; ++d)
#pragma unroll
            for (int r = 0; r < 16; ++r) X[(d * 16 + r) * 64] = o[d][r] * rli[r] * T.lam;
    }
    asm volatile("s_waitcnt lgkmcnt(0)\n\ts_barrier" ::: "memory");
    if (sub == 0) {
        float ss[16];
#pragma unroll
        for (int r = 0; r < 16; ++r) { float s = 0.f;
#pragma unroll
            for (int d = 0; d < 4; ++d) { const float v = o[d][r] * rli[r] - X[(d * 16 + r) * 64]; o[d][r] = v; s += v * v; }
            ss[r] = s; }
#pragma unroll
        for (int r = 0; r < 16; ++r) {
#pragma unroll
            for (int m = 1; m < 32; m <<= 1) ss[r] += __shfl_xor(ss[r], m);
            ss[r] = rsqrtf(ss[r] * (1.0f / 128.0f) + NORM_EPS) * (1.0f - LAM_INIT); }
        float gg[4];
#pragma unroll
        for (int d = 0; d < 4; ++d) gg[d] = T.subg[d * 32 + r32];
#pragma unroll
        for (int r = 0; r < 16; ++r) { const int rowi = rg * 32 + crow(r, hi);
            if (rowi < nvalid) { bf16_t* op = T.MIX + (size_t)(qrow0 + rowi) * D + h * 128 + r32;
#pragma unroll
                for (int d = 0; d < 4; ++d) { const float y = o[d][r] * ss[r] * gg[d]; op[d * 32] = (bf16_t)(cvtpk(y, y) & 0xffffu); } } }
    }
    asm volatile("s_waitcnt lgkmcnt(0)\n\ts_barrier" ::: "memory");
}

__device__ __forceinline__ void meta_combine(const Tensors& T, const float* parts, int bh, int lane) {
    const int r32 = lane & 31, hi = lane >> 5, b = bh >> 2, h = bh & 3;
    float osub[2][4][8];
#pragma unroll
    for (int sub = 0; sub < 2; ++sub) {
        float M[8], L[8];
#pragma unroll
        for (int r = 0; r < 8; ++r) { M[r] = -INFINITY; L[r] = 0.f; }
#pragma unroll
        for (int d = 0; d < 4; ++d)
#pragma unroll
            for (int r = 0; r < 8; ++r) osub[sub][d][r] = 0.f;
#pragma unroll 1
        for (int c = 0; c < META_CHUNKS; ++c) { asm volatile("" ::: "memory"); const float* pp = parts + ((size_t)(bh * META_CHUNKS + c) * 2 + sub) * PART_F32;
#pragma unroll
            for (int r = 0; r < 8; ++r) { const int row = crow(r, hi); const float mc = pp[row], lc = pp[32 + row];
                const float mn = __builtin_fmaxf(M[r], mc), fo = __builtin_amdgcn_exp2f(M[r] - mn), fc = __builtin_amdgcn_exp2f(mc - mn);
                M[r] = mn; L[r] = L[r] * fo + lc * fc;
#pragma unroll
                for (int d = 0; d < 4; ++d) osub[sub][d][r] = osub[sub][d][r] * fo + pp[64 + (d * 8 + r) * 64 + lane] * fc; } }
#pragma unroll
        for (int r = 0; r < 8; ++r) { const float rl = 1.0f / L[r];
#pragma unroll
            for (int d = 0; d < 4; ++d) osub[sub][d][r] *= rl; }
    }
    float gg[4];
#pragma unroll
    for (int d = 0; d < 4; ++d) gg[d] = T.subg[d * 32 + r32];
#pragma unroll
    for (int r = 0; r < 8; ++r) { float v[4], s = 0.f;
#pragma unroll
        for (int d = 0; d < 4; ++d) { v[d] = osub[0][d][r] - T.lam * osub[1][d][r]; s += v[d] * v[d]; }
#pragma unroll
        for (int m = 1; m < 32; m <<= 1) s += __shfl_xor(s, m);
        const float sc = rsqrtf(s * (1.0f / 128.0f) + NORM_EPS) * (1.0f - LAM_INIT);
        bf16_t* op = T.MIX + (size_t)(RMETA + NMETA * b + crow(r, hi)) * D + h * 128 + r32;
#pragma unroll
        for (int d = 0; d < 4; ++d) { const float y = v[d] * sc * gg[d]; op[d * 32] = (bf16_t)(cvtpk(y, y) & 0xffffu); } }
}
#undef MX3
#undef WAITBAR
#undef SBAR
#undef PIN
#undef EX
}
#define XB_TMO      128
#define XB_XCNT(j)  (256  + 64 * (j))
#define XB_XSUB(j)  (1280 + 64 * (j))
#define XB_XGEN(j)  (2304 + 64 * (j))
#define XB_TOP      3328
#define XB_TOPGEN   3392
#define XCD_BAR_WORDS 3456
#define XB_SPIN_CAP (1u << 18)

__device__ __forceinline__ unsigned xb_ld(unsigned* p)              { return __hip_atomic_load(p, __ATOMIC_RELAXED, __HIP_MEMORY_SCOPE_AGENT); }
__device__ __forceinline__ unsigned xb_add(unsigned* p, unsigned v) { return __hip_atomic_fetch_add(p, v, __ATOMIC_RELAXED, __HIP_MEMORY_SCOPE_AGENT); }
__device__ __forceinline__ unsigned xb_xcc_id() { return (unsigned)__builtin_amdgcn_s_getreg((3 << 11) | 20) & 0xFu; }
#define XB_SPIN(cond, bar) do { unsigned _sp = 0; while (cond) { __builtin_amdgcn_s_sleep(1); \
    if ((++_sp & 255u) == 0u) { if (xb_ld(&(bar)[XB_TMO])) break; if (_sp > XB_SPIN_CAP) { atomicAdd(&(bar)[XB_TMO], 1u); break; } } } } while (0)

struct XcdBarrier {
    unsigned* bar; unsigned x;
    volatile LAS unsigned* st;
};

__device__ __forceinline__ XcdBarrier xcd_barrier_post(unsigned* bar, volatile LAS unsigned* st) {
    XcdBarrier b; b.bar = bar; b.x = xb_xcc_id(); b.st = st;
    if (threadIdx.x == 0) (void)xb_add(&bar[XB_XCNT(b.x)], 1u);
    return b;
}
__device__ __forceinline__ void xcd_barrier_complete(unsigned* bar, unsigned x, unsigned& nloc, unsigned& nx) {
    const unsigned G = gridDim.x * gridDim.y * gridDim.z;
    unsigned sum, cnt, mine, sp = 0u;
    for (;;) {
        sum = 0u; cnt = 0u; mine = 0u;
#pragma unroll
        for (unsigned j = 0; j < 16; ++j) { const unsigned c = xb_ld(&bar[XB_XCNT(j)]); sum += c; cnt += (c > 0u) ? 1u : 0u; mine = (j == x) ? c : mine; }
        if (sum == G) break;
        __builtin_amdgcn_s_sleep(1);
        if ((++sp & 255u) == 0u) { if (xb_ld(&bar[XB_TMO])) break; if (sp > XB_SPIN_CAP) { atomicAdd(&bar[XB_TMO], 1u); break; } }
    }
    nloc = mine > 0u ? mine : 1u; nx = cnt > 0u ? cnt : 1u;
}

__device__ __forceinline__ void xcd_barrier(const XcdBarrier& b) {
    asm volatile("s_waitcnt vmcnt(0)" ::: "memory");
    __syncthreads();
    if (threadIdx.x == 0) {
        unsigned* bar = b.bar;
        __builtin_amdgcn_s_waitcnt(0);
        unsigned nloc = b.st[0], nx = b.st[1];
        if (nloc == 0u) { xcd_barrier_complete(bar, b.x, nloc, nx); b.st[0] = nloc; b.st[1] = nx; }
        const unsigned old = xb_add(&bar[XB_XSUB(b.x)], 1u);
        const unsigned gen = old / nloc;
        if (old + 1u == (gen + 1u) * nloc) {
            __builtin_amdgcn_fence(__ATOMIC_RELEASE, "agent");
            asm volatile("s_waitcnt vmcnt(0)" ::: "memory");
            const unsigned og = xb_add(&bar[XB_TOP], 1u);
            const unsigned tg = og / nx;
            if (og + 1u == (tg + 1u) * nx) xb_add(&bar[XB_TOPGEN], 1u);
            else XB_SPIN(xb_ld(&bar[XB_TOPGEN]) == tg, bar);
            __builtin_amdgcn_fence(__ATOMIC_ACQUIRE, "agent");
            xb_add(&bar[XB_XGEN(b.x)], 1u);
            asm volatile("s_waitcnt vmcnt(0)" ::: "memory");
        } else {
            XB_SPIN(xb_ld(&bar[XB_XGEN(b.x)]) == gen, bar);
            __builtin_amdgcn_fence(__ATOMIC_ACQUIRE, "agent");
            asm volatile("s_waitcnt vmcnt(0)" ::: "memory");
        }
    }
    __syncthreads();
}
struct Ctx {
    LAS unsigned char* lds; int wave, G, gw, NGW;
    const float* in[17]; float* out; unsigned char* ws;
};
__device__ __forceinline__ int colmap_in(int np) {
    const int pn = np >> 8, c = np & 255, bj = c >> 7, cc = c & 127;
    if (pn < 4) return (pn >> 1) * AW + ((pn & 1) * 4 + (cc >> 5)) * 64 + bj * 32 + (cc & 31);
    if (pn < 6) return 2 * AW + (pn - 4) * 256 + c;
    if (pn < 10) return (bj ? 3 * AW + 2 * CWID : 3 * AW) + (pn - 6) * 128 + cc;
    return 3 * AW + CWID + (pn - 10) * 256 + c;
}
__device__ __forceinline__ void tr_item(const float* W, int N, int k0, int c0, bf16* WT, int r0, int K, LAS float* scr, int lane) {
    float t_[32];
#pragma unroll
    for (int i = 0; i < 32; ++i) t_[i] = W[(size_t)(k0 + 2 * i + (lane >> 5)) * N + c0 + (lane & 31)];
#pragma unroll
    for (int i = 0; i < 32; ++i) scr[(2 * i + (lane >> 5)) * 33 + (lane & 31)] = t_[i];
    LDS_WAIT(); asm volatile("" ::: "memory");
    const int c = lane & 7;
#pragma unroll
    for (int j = 0; j < 4; ++j) { const int n = (lane >> 3) + 8 * j; const LAS float* s = scr + (8 * c) * 33 + n;
        v4u o; o.x = pk2(s[0 * 33], s[1 * 33]); o.y = pk2(s[2 * 33], s[3 * 33]); o.z = pk2(s[4 * 33], s[5 * 33]); o.w = pk2(s[6 * 33], s[7 * 33]);
        *(GAS v4u*)(WT + (size_t)(r0 + n) * K + k0 + 8 * c) = o; }
    LDS_WAIT(); asm volatile("" ::: "memory");
}
__device__ __forceinline__ void tr_item8(const float* W, int N, int k0, int c0, unsigned char* WT, int r0, int K, LAS float* scr, int lane) {
    float t_[32];
#pragma unroll
    for (int i = 0; i < 32; ++i) t_[i] = W[(size_t)(k0 + 2 * i + (lane >> 5)) * N + c0 + (lane & 31)];
#pragma unroll
    for (int i = 0; i < 32; ++i) scr[(2 * i + (lane >> 5)) * 33 + (lane & 31)] = t_[i];
    LDS_WAIT(); asm volatile("" ::: "memory");
    const int c = lane & 3;
#pragma unroll
    for (int j = 0; j < 2; ++j) { const int n = (lane >> 2) + 16 * j; const LAS float* s = scr + (16 * c) * 33 + n; v4u o;
#pragma unroll
        for (int q = 0; q < 4; ++q) { int w = __builtin_amdgcn_cvt_pk_fp8_f32(64.f * s[(4 * q) * 33], 64.f * s[(4 * q + 1) * 33], 0, false);
            w = __builtin_amdgcn_cvt_pk_fp8_f32(64.f * s[(4 * q + 2) * 33], 64.f * s[(4 * q + 3) * 33], w, true); o[q] = (unsigned)w; }
        *(GAS v4u*)(WT + (size_t)(r0 + n) * K + k0 + 16 * c) = o; }
    LDS_WAIT(); asm volatile("" ::: "memory");
}
__device__ __forceinline__ void expert_item(Ctx& F, int it, LAS float* scr, int lane) {
    constexpr int I_GU = 16 * 128, I_DN = 32 * 32, I_E = I_GU + I_DN;
    unsigned char* W1 = F.ws + WS_W1; unsigned char* W2 = F.ws + WS_W2;
    const int e = it / I_E; int r = it - e * I_E;
    if (r < I_GU) { const int kb = r / 128, nb = r % 128, np = 32 * nb, c = np & 255; const float* src = ((c >> 7) ? F.in[14] : F.in[13]) + (size_t)e * D * FF;
        tr_item8(src, FF, 64 * kb, (np >> 8) * 128 + (c & 127), W1 + (size_t)e * 2 * FF * D, np, D, scr, lane); return; } r -= I_GU;
    { const int kb = r / 32, nb = r % 32; tr_item8(F.in[15] + (size_t)e * FF * D, D, 64 * kb, 32 * nb, W2 + (size_t)e * D * FF, 32 * nb, FF, scr, lane); }
}
__device__ __forceinline__ void p0_prologue(Ctx& F) {
    const int lane_ = hw_lane(), tid_ = F.wave * 64 + lane_; (void)tid_;
    LAS float* scr = (LAS float*)(F.lds + RING_OFF + F.wave * 16384);
    bf16* WIN = (bf16*)(F.ws + WS_WIN); bf16* WOUT = (bf16*)(F.ws + WS_WOUT);
    constexpr int I_IN = 16 * 96, I_OUT = 16 * 32, NITEMS = I_IN + I_OUT;
    for (int it = F.gw; it < NITEMS; it += F.NGW) {
        int r = it;
        if (r < I_IN) { const int kb = r / 96, nb = r % 96; tr_item(F.in[3], NPROJ, 64 * kb, colmap_in(32 * nb), WIN, 32 * nb, D, scr, lane_); continue; } r -= I_IN;
        { const int kb = r / 32, nb = r % 32; tr_item(F.in[10], D, 64 * kb, 32 * nb, WOUT, 32 * nb, D, scr, lane_); }
    }
    bf16* XN = (bf16*)(F.ws + WS_XN); const float* gsrc = F.in[2];
    f32x4 gv[4];
#pragma unroll
    for (int j = 0; j < 2; ++j) { gv[2 * j] = *(const GAS f32x4*)(gsrc + 8 * lane_ + 512 * j); gv[2 * j + 1] = *(const GAS f32x4*)(gsrc + 8 * lane_ + 512 * j + 4); }
    for (int r = F.gw; r < RP; r += F.NGW) {
        GAS v4u* o = (GAS v4u*)(XN + (size_t)r * D + 8 * lane_);
        if (r >= RV) { o[0] = (v4u){0u, 0u, 0u, 0u}; o[64] = (v4u){0u, 0u, 0u, 0u}; continue; }
        const float* src = r < RX ? F.in[0] + (size_t)r * D : F.in[1] + (size_t)((r - RX) & (NMETA - 1)) * D;
        f32x4 v[4]; float s = 0.f;
#pragma unroll
        for (int j = 0; j < 2; ++j) { v[2 * j] = *(const GAS f32x4*)(src + 8 * lane_ + 512 * j); v[2 * j + 1] = *(const GAS f32x4*)(src + 8 * lane_ + 512 * j + 4); }
#pragma unroll
        for (int j = 0; j < 4; ++j) s += (v[j].x * v[j].x + v[j].y * v[j].y) + (v[j].z * v[j].z + v[j].w * v[j].w);
        const float rstd = rsqrtf(wave_sum(s) * (1.f / D) + NORM_EPS);
#pragma unroll
        for (int j = 0; j < 2; ++j) { const f32x4 a = v[2 * j] * rstd * gv[2 * j], b = v[2 * j + 1] * rstd * gv[2 * j + 1];
            o[64 * j] = (v4u){pk2(a.x, a.y), pk2(a.z, a.w), pk2(b.x, b.y), pk2(b.z, b.w)}; }
    }
    { char* VI = (char*)(F.ws + WS_V);
      for (int i = F.gw; i < BATCH * 4 * 8; i += F.NGW) { const int bh = i >> 3, q = i & 7;
          *(GAS v4u*)(VI + (size_t)bh * KV_TILES * 8192 + q * 1024 + lane_ * 16) = (v4u){0u, 0u, 0u, 0u}; } }
    { bf16* RT = (bf16*)(F.ws + WS_RTAB); float* RG = (float*)(F.ws + WS_RTAB + (size_t)2 * 16 * 1032 * 2); const float* wr = F.in[12]; const float* gs = F.in[11];
      for (int i = F.gw * 64 + lane_; i < D * NEXP; i += F.NGW * 64) { const int k = i >> 4, e = i & 15; const float w = wr[i] * gs[k];
          const unsigned hb = pk2(w, w) & 0xffffu; const float hf = __uint_as_float(hb << 16); const unsigned lb = pk2(w - hf, w - hf) & 0xffffu;
          RT[e * 1032 + k] = (bf16)hb; RT[16 * 1032 + e * 1032 + k] = (bf16)lb; }
      for (int i = F.gw * 64 + lane_; i < D; i += F.NGW * 64) RG[i] = gs[i]; }
    float* rc = (float*)(F.ws + WS_ROPE); float* rs = rc + LSEQ * 32;
    for (int idx = (F.gw * 64 + lane_); idx < LSEQ * 32; idx += F.NGW * 64) {
        const int pos = idx >> 5, i = idx & 31;
        const float inv_freq = exp2f(-(float)i * (13.287712379549449f / 32.0f));
        const double ang = (double)pos * (double)inv_freq;
        const double n = __builtin_rint(ang * 0.15915494309189535);
        double rr = __builtin_fma(-n, 6.283185307179586, ang); rr = __builtin_fma(-n, 2.4492935982947064e-16, rr);
        const double z = rr * rr; double cs = 0.0, sn = 0.0;
        { double tc = 1.0, ts = 1.0;
#pragma unroll
          for (int k = 0; k < 14; ++k) { cs += tc; sn += ts; tc = -tc * z * (1.0 / (double)((2 * k + 1) * (2 * k + 2))); ts = -ts * z * (1.0 / (double)((2 * k + 2) * (2 * k + 3))); } }
        rc[idx] = (float)cs; rs[idx] = (float)(sn * rr);
    }
}
__device__ __forceinline__ void conv_rows(Ctx& F) {
    const int lane_ = hw_lane(), tid_ = F.wave * 64 + lane_; (void)tid_;
    const bf16* U = (const bf16*)(F.ws + WS_U); const bf16* CBb = (const bf16*)(F.ws + WS_CB); bf16* MIX = (bf16*)(F.ws + WS_XN);
    const float* cw = F.in[4]; float w[3][8];
#pragma unroll
    for (int j = 0; j < 3; ++j)
#pragma unroll
        for (int i = 0; i < 8; ++i) w[j][i] = cw[j * CWID + 8 * lane_ + i];
    for (int g = F.gw; g < RV / 4; g += F.NGW) {
        const int r0 = 4 * g; int prev, next;
        if (r0 < RX) { const int b = r0 >> 13, s = r0 & (SEQ - 1); prev = s > 0 ? r0 - 1 : RMETA + NMETA * b + NMETA - 1; next = s + 3 < SEQ - 1 ? r0 + 4 : -1; }
        else { const int m = r0 - RX, b = m >> 4, j = m & (NMETA - 1); prev = j > 0 ? r0 - 1 : -1; next = j + 3 < NMETA - 1 ? r0 + 4 : b * SEQ; }
        const v4u z = (v4u){0u, 0u, 0u, 0u};
        v4u uu[6], cb[4];
        uu[0] = prev >= 0 ? *(const GAS v4u*)(U + (size_t)prev * CWID + 8 * lane_) : z;
#pragma unroll
        for (int q = 0; q < 4; ++q) { uu[1 + q] = *(const GAS v4u*)(U + (size_t)(r0 + q) * CWID + 8 * lane_); cb[q] = *(const GAS v4u*)(CBb + (size_t)(r0 + q) * CWID + 8 * lane_); }
        uu[5] = next >= 0 ? *(const GAS v4u*)(U + (size_t)next * CWID + 8 * lane_) : z;
#pragma unroll
        for (int q = 0; q < 4; ++q) { float o[8];
#pragma unroll
            for (int t = 0; t < 4; ++t) {
                o[2 * t] = bf_lo(cb[q][t]) * (w[0][2 * t] * bf_lo(uu[q][t]) + w[1][2 * t] * bf_lo(uu[q + 1][t]) + w[2][2 * t] * bf_lo(uu[q + 2][t]));
                o[2 * t + 1] = bf_hi(cb[q][t]) * (w[0][2 * t + 1] * bf_hi(uu[q][t]) + w[1][2 * t + 1] * bf_hi(uu[q + 1][t]) + w[2][2 * t + 1] * bf_hi(uu[q + 2][t])); }
            *(GAS v4u*)(MIX + (size_t)(r0 + q) * D + AW + 8 * lane_) = (v4u){pk2(o[0], o[1]), pk2(o[2], o[3]), pk2(o[4], o[5]), pk2(o[6], o[7])}; }
    }
}
__device__ __forceinline__ void p4_norm_router(Ctx& F) {
    const int lane_ = hw_lane(), tid_ = F.wave * 64 + lane_;
    typedef short bf16x8_t __attribute__((ext_vector_type(8)));
    constexpr int WP = D + 8;
    LAS bf16* Wh = (LAS bf16*)(F.lds + RING_OFF); LAS bf16* Wl = Wh + NEXP * WP; LAS float* G = (LAS float*)(F.lds + RING_OFF + 2 * NEXP * WP * 2);
    { const v4u* src = (const v4u*)(F.ws + WS_RTAB); LAS v4u* dst = (LAS v4u*)(F.lds + RING_OFF);
      for (int i = tid_; i < (int)((2 * NEXP * WP * 2 + D * 4) / 16); i += 512) dst[i] = src[i]; }
    __syncthreads();
    unsigned char* HN2 = F.ws + WS_HN2; const bf16* H1B = (const bf16*)(F.ws + WS_H1B); float* AFF = (float*)(F.ws + WS_AFF); const float* H1M = (const float*)(F.ws + WS_H1M);
    const int rl = lane_ & 15, kq = lane_ >> 4;
    constexpr int N_EITEMS = NEXP * (16 * 128 + 32 * 32);
    LAS float* escr = (LAS float*)(F.lds + RING_OFF + 70656 + F.wave * 8448);
    int eit = F.gw;
    for (int t = F.gw; t < RV / 16 + F.NGW; t += F.NGW) {
        asm volatile("" ::: "memory");
        if (t >= RV / 16) { for (; eit < N_EITEMS; eit += F.NGW) expert_item(F, eit, escr, lane_); break; }
        const int row = 16 * t + rl;
        const bool xrow = t < RX / 16;
        const bf16* srcb = H1B + (size_t)row * D + 8 * kq; const float* srcf = H1M + (size_t)(xrow ? 0 : row - RX) * D + 8 * kq;
#define P4_LOAD8(s0) do { if (xrow) { _Pragma("unroll") for (int s = 0; s < 8; ++s) xr[s] = *(const GAS v4u*)(srcb + 32 * ((s0) + s)); } \
        else { _Pragma("unroll") for (int s = 0; s < 8; ++s) { const f32x4 a = *(const GAS f32x4*)(srcf + 32 * ((s0) + s)), b2 = *(const GAS f32x4*)(srcf + 32 * ((s0) + s) + 4); \
            xr[s] = (v4u){pk2(a.x, a.y), pk2(a.z, a.w), pk2(b2.x, b2.y), pk2(b2.z, b2.w)}; } } } while (0)
        v4u xr[8];
        f32x4 acc = (f32x4){0.f, 0.f, 0.f, 0.f}; float ss = 0.f;
#pragma unroll 1
        for (int s0 = 0; s0 < 32; s0 += 8) {
            asm volatile("" ::: "memory");
            P4_LOAD8(s0);
#pragma unroll
            for (int s = 0; s < 8; ++s) {
                const bf16x8_t bh = *(const LAS bf16x8_t*)(Wh + rl * WP + 32 * (s0 + s) + 8 * kq), bl = *(const LAS bf16x8_t*)(Wl + rl * WP + 32 * (s0 + s) + 8 * kq);
                const bf16x8_t af = __builtin_bit_cast(bf16x8_t, xr[s]);
                acc = __builtin_amdgcn_mfma_f32_16x16x32_bf16(af, bh, acc, 0, 0, 0);
                acc = __builtin_amdgcn_mfma_f32_16x16x32_bf16(af, bl, acc, 0, 0, 0);
#pragma unroll
                for (int q = 0; q < 4; ++q) { const float lo = bf_lo(xr[s][q]), hi = bf_hi(xr[s][q]); ss += lo * lo + hi * hi; } } }
        ss += __shfl_xor(ss, 16); ss += __shfl_xor(ss, 32);
        const float rstd = rsqrtf(ss * (1.f / D) + NORM_EPS);
        unsigned char* dst = HN2 + (size_t)row * D + 8 * kq;
#pragma unroll 1
        for (int s0 = 0; s0 < 32; s0 += 8) {
            asm volatile("" ::: "memory");
            P4_LOAD8(s0);
#pragma unroll
            for (int s = 0; s < 8; ++s) { const f32x4 g0 = *(const LAS f32x4*)(G + 32 * (s0 + s) + 8 * kq), g1 = *(const LAS f32x4*)(G + 32 * (s0 + s) + 8 * kq + 4);
                int w0 = __builtin_amdgcn_cvt_pk_fp8_f32(bf_lo(xr[s][0]) * rstd * g0.x, bf_hi(xr[s][0]) * rstd * g0.y, 0, false); w0 = __builtin_amdgcn_cvt_pk_fp8_f32(bf_lo(xr[s][1]) * rstd * g0.z, bf_hi(xr[s][1]) * rstd * g0.w, w0, true);
                int w1 = __builtin_amdgcn_cvt_pk_fp8_f32(bf_lo(xr[s][2]) * rstd * g1.x, bf_hi(xr[s][2]) * rstd * g1.y, 0, false); w1 = __builtin_amdgcn_cvt_pk_fp8_f32(bf_lo(xr[s][3]) * rstd * g1.z, bf_hi(xr[s][3]) * rstd * g1.w, w1, true);
                *(GAS v2u*)(dst + 32 * (s0 + s)) = (v2u){(unsigned)w0, (unsigned)w1}; } }
#undef P4_LOAD8
#pragma unroll
        for (int reg = 0; reg < 4; ++reg) { const int rr = 4 * kq + reg; const float lg = acc[reg] * __shfl(rstd, rr);
            float mx = lg;
#pragma unroll
            for (int m = 1; m < 16; m <<= 1) mx = fmaxf(mx, __shfl_xor(mx, m));
            const float ex = expf(lg - mx); float sm = ex;
#pragma unroll
            for (int m = 1; m < 16; m <<= 1) sm += __shfl_xor(sm, m);
            const int r = 16 * t + rr; const int b = r < RX ? r >> 13 : (r - RX) >> 4, pos = r < RX ? NMETA + (r & (SEQ - 1)) : ((r - RX) & (NMETA - 1));
            AFF[((size_t)b * NEXP + rl) * LSEQ + pos] = ex / sm; }
        for (int j = 0; j < 12 && eit < N_EITEMS; ++j, eit += F.NGW) expert_item(F, eit, escr, lane_);
    }
}
__device__ __forceinline__ void p5_topk(Ctx& F, int job) {
    const int lane_ = hw_lane(), tid_ = F.wave * 64 + lane_; (void)tid_;
    LAS unsigned* hist = (LAS unsigned*)(F.lds + RING_OFF); LAS unsigned* ctl = hist + 256; LAS unsigned* wsum = hist + 512;
    const int b = job >> 4, e = job & 15;
    const float* AFF = (const float*)(F.ws + WS_AFF) + (size_t)job * LSEQ;
    int* IDX = (int*)(F.ws + WS_IDX); float* GATE = (float*)(F.ws + WS_GATE); int* INV = (int*)(F.ws + WS_INV);
    constexpr int PER = 17;
    unsigned key[PER];
#pragma unroll
    for (int k = 0; k < PER; ++k) { const int i = tid_ * PER + k; key[k] = i < LSEQ ? __float_as_uint(AFF[i]) : 0u; }
    unsigned prefix = 0u, need = CAP;
#pragma unroll 1
    for (int p = 0; p < 4; ++p) {
        const int shift = 24 - 8 * p;
        if (tid_ < 256) hist[tid_] = 0u;
        __syncthreads();
        if (p == 0) {
#pragma unroll
            for (int k = 0; k < PER; ++k) { const int i = tid_ * PER + k; const int bin = i < LSEQ ? (int)(key[k] >> 24) : -1;
                unsigned long long act = __ballot(bin >= 0);
                while (act) { const int leader = __builtin_ctzll(act); const int bl = __builtin_amdgcn_readlane(bin, leader); const unsigned long long m = __ballot(bin == bl);
                    if (lane_ == leader) __hip_atomic_fetch_add(&hist[bl], (unsigned)__builtin_popcountll(m), __ATOMIC_RELAXED, __HIP_MEMORY_SCOPE_WORKGROUP);
                    act &= ~m; } }
        } else {
#pragma unroll
            for (int k = 0; k < PER; ++k) { const int i = tid_ * PER + k;
                if (i < LSEQ && (key[k] >> (shift + 8)) == prefix) __hip_atomic_fetch_add(&hist[(key[k] >> shift) & 255u], 1u, __ATOMIC_RELAXED, __HIP_MEMORY_SCOPE_WORKGROUP); }
        }
        __syncthreads();
        if (F.wave == 0) {
            const unsigned c0 = hist[4 * lane_], c1 = hist[4 * lane_ + 1], c2 = hist[4 * lane_ + 2], c3 = hist[4 * lane_ + 3], s = c0 + c1 + c2 + c3;
            unsigned t = s;
#pragma unroll
            for (int o = 1; o < 64; o <<= 1) { const unsigned v = __shfl_down(t, o); if (lane_ + o < 64) t += v; }
            const unsigned above = t - s;
            if (above < need && need <= t) { unsigned cum = above, sel;
                if (cum + c3 >= need) sel = 3; else { cum += c3; if (cum + c2 >= need) sel = 2; else { cum += c2; if (cum + c1 >= need) sel = 1; else { cum += c1; sel = 0; } } }
                ctl[0] = (prefix << 8) | (4u * lane_ + sel); ctl[1] = need - cum; }
        }
        __syncthreads();
        prefix = ctl[0]; need = ctl[1];
        __syncthreads();
    }
    const unsigned T = prefix, need_eq = need;
    unsigned cnt = 0u;
#pragma unroll
    for (int k = 0; k < PER; ++k) { const int i = tid_ * PER + k; if (i < LSEQ) cnt += (key[k] > T ? 65536u : 0u) + (key[k] == T ? 1u : 0u); }
    unsigned inc = cnt;
#pragma unroll
    for (int o = 1; o < 64; o <<= 1) { const unsigned t = __shfl_up(inc, o); if (lane_ >= o) inc += t; }
    if (lane_ == 63) wsum[F.wave] = inc;
    __syncthreads();
    unsigned base = inc - cnt;
    for (int w = 0; w < F.wave; ++w) base += wsum[w];
    unsigned gt_before = base >> 16, eq_before = base & 65535u;
#pragma unroll
    for (int k = 0; k < PER; ++k) { const int i = tid_ * PER + k;
        if (i < LSEQ) {
            const bool isgt = key[k] > T, iseq = key[k] == T; const bool sel = isgt || (iseq && eq_before < need_eq);
            const int m = i < NMETA ? RMETA + NMETA * b + i : b * SEQ + i - NMETA;
            int yrow = -1;
            if (sel) { const unsigned slot = gt_before + (eq_before < need_eq ? eq_before : need_eq); yrow = e * EPAD + b * CAP + (int)slot; IDX[yrow] = m; GATE[yrow] = __uint_as_float(key[k]); }
            INV[(size_t)m * NEXP + e] = yrow;
            gt_before += isgt ? 1u : 0u; eq_before += iseq ? 1u : 0u;
        } }
    if (b == BATCH - 1) for (int t = tid_; t < EPAD - EROWS; t += 512) { IDX[e * EPAD + EROWS + t] = 0; GATE[e * EPAD + EROWS + t] = 0.f; }
    __syncthreads();
}
__device__ __forceinline__ void p8_final(Ctx& F) {
    const int lane_ = hw_lane(), tid_ = F.wave * 64 + lane_; (void)tid_;
    const int* INV = (const int*)(F.ws + WS_INV); const unsigned char* Y = F.ws + WS_Y; const bf16* H1B = (const bf16*)(F.ws + WS_H1B);
    const float* gsrc = F.in[16]; float gv[16];
#pragma unroll
    for (int j = 0; j < 2; ++j)
#pragma unroll
        for (int i = 0; i < 8; ++i) gv[8 * j + i] = gsrc[8 * lane_ + 512 * j + i];
    for (int g = F.gw; g < RX / 4; g += F.NGW) {
        const int r0 = 4 * g;
        const int iv = INV[(size_t)r0 * NEXP + lane_];
        unsigned long long mask = __ballot(iv >= 0);
        float a[4][16];
#pragma unroll
        for (int q = 0; q < 4; ++q)
#pragma unroll
            for (int j = 0; j < 2; ++j) { const v4u w = *(const GAS v4u*)(H1B + (size_t)(r0 + q) * D + 8 * lane_ + 512 * j);
#pragma unroll
                for (int t = 0; t < 4; ++t) { a[q][8 * j + 2 * t] = bf_lo(w[t]); a[q][8 * j + 2 * t + 1] = bf_hi(w[t]); } }
        while (mask) {
            v2u w[4][2]; float on[4];
#pragma unroll
            for (int q = 0; q < 4; ++q) { const unsigned mq = (unsigned)(mask >> (16 * q)) & 0xffffu; const int e = mq ? __builtin_ctz(mq) : 0;
                const int yrow = __builtin_amdgcn_readlane(iv, 16 * q + e); on[q] = mq ? (1.f / 16.f) : 0.f;
                mask &= ~((unsigned long long)(mq ? 1u : 0u) << (16 * q + e));
                const unsigned char* yp = Y + (size_t)(mq ? yrow : 0) * D + 8 * lane_;
                w[q][0] = *(const GAS v2u*)yp; w[q][1] = *(const GAS v2u*)(yp + 512); }
#pragma unroll
            for (int q = 0; q < 4; ++q)
#pragma unroll
                for (int j = 0; j < 2; ++j)
#pragma unroll
                    for (int t = 0; t < 2; ++t) { typedef float f2_t __attribute__((ext_vector_type(2)));
                        const f2_t lo = __builtin_amdgcn_cvt_pk_f32_fp8((int)w[q][j][t], false), hh = __builtin_amdgcn_cvt_pk_f32_fp8((int)w[q][j][t], true);
                        a[q][8 * j + 4 * t] += on[q] * lo.x; a[q][8 * j + 4 * t + 1] += on[q] * lo.y; a[q][8 * j + 4 * t + 2] += on[q] * hh.x; a[q][8 * j + 4 * t + 3] += on[q] * hh.y; }
        }
#pragma unroll
        for (int q = 0; q < 4; ++q) { float s = 0.f;
#pragma unroll
            for (int i = 0; i < 16; ++i) s += a[q][i] * a[q][i];
            const float rstd = rsqrtf(wave_sum(s) * (1.f / D) + NORM_EPS);
            float* row = F.out + (size_t)(r0 + q) * D + 8 * lane_;
#pragma unroll
            for (int j = 0; j < 2; ++j) { *(GAS f32x4*)(row + 512 * j) = (f32x4){a[q][8 * j] * rstd * gv[8 * j], a[q][8 * j + 1] * rstd * gv[8 * j + 1], a[q][8 * j + 2] * rstd * gv[8 * j + 2], a[q][8 * j + 3] * rstd * gv[8 * j + 3]};
                *(GAS f32x4*)(row + 512 * j + 4) = (f32x4){a[q][8 * j + 4] * rstd * gv[8 * j + 4], a[q][8 * j + 5] * rstd * gv[8 * j + 5], a[q][8 * j + 6] * rstd * gv[8 * j + 6], a[q][8 * j + 7] * rstd * gv[8 * j + 7]}; } }
    }
}
constexpr int NWAVES = 8;
#ifndef MK_N_LAUNCHES
#define MK_N_LAUNCHES 1
#endif
constexpr int N_PHASES = 9;
struct Args { const float* in[17]; float* out; unsigned char* ws; int ph_lo, ph_hi; };
static_assert(sizeof(Args) == 17 * 8 + 8 + 8 + 8, "Args has no padding");

__global__ void __launch_bounds__(NWAVES * 64, 2) hymba_fwd(Args args) {
    extern __shared__ __attribute__((aligned(16))) unsigned char lds_raw[];
    Ctx F;
    F.lds = (LAS unsigned char*)lds_raw;
    F.wave = __builtin_amdgcn_readfirstlane((int)threadIdx.x >> 6);
    F.G = gridDim.x; F.gw = blockIdx.x * NWAVES + F.wave; F.NGW = F.G * NWAVES;
#pragma unroll
    for (int i = 0; i < 17; ++i) F.in[i] = args.in[i];
    F.out = args.out; F.ws = args.ws;
    volatile LAS unsigned* MISC = (volatile LAS unsigned*)(F.lds + MISC_OFF);
    { const int l0 = hw_lane(); if (F.wave == 0) MISC[l0] = 0u; }
    __syncthreads();
    unsigned* ctl = (unsigned*)(F.ws + WS_CTL);
    XcdBarrier bar; bar.bar = ctl + CW_BAR; bar.x = 0; bar.st = nullptr;
    if (MK_N_LAUNCHES == 1) bar = xcd_barrier_post(ctl + CW_BAR, MISC + 8);
    const int lo = args.ph_lo, hi = args.ph_hi;
#define IN(k) (lo <= (k) && (k) < hi)
#define SEAM(k) do { if (IN(k) && IN((k) + 1)) xcd_barrier(bar); } while (0)
#ifndef PROBE_REPEAT
#define PROBE_REPEAT -1
#endif
#define REP(k) for (int rep_ = 0; rep_ < ((PROBE_REPEAT == (k)) ? 2 : 1); ++rep_)
#define REPBAR(k) do { if (PROBE_REPEAT == (k) && rep_ == 0) xcd_barrier(bar); } while (0)

    if (IN(0)) { REP(0) { p0_prologue(F); REPBAR(0); } SEAM(0); }

    if (IN(1)) {
        pg8::Gemm g{(const pg8::bf16_t*)(F.ws + WS_XN), (const pg8::bf16_t*)(F.ws + WS_WIN), D};
        pg8::StaticOrder S; S.init(RX / 256, NPROJ / 256, F.G, (int)blockIdx.x);
        pg8::EpiInProj E{(pg8::bf16_t*)(F.ws + WS_Q), (pg8::bf16_t*)(F.ws + WS_K), (pg8::bf16_t*)(F.ws + WS_V), (pg8::bf16_t*)(F.ws + WS_U), (pg8::bf16_t*)(F.ws + WS_CB),
                         (const float*)(F.ws + WS_ROPE), (const float*)(F.ws + WS_ROPE) + LSEQ * 32, ctl + CW_KMAX};
        pg8::RowIdentity AM;
        REP(1) { pg8::gemm_phase<pg8::EpiInProj, pg8::StaticOrder, pg8::RowIdentity, true>(F.lds + RING_OFF, g, S, E, AM, F.wave); REPBAR(1); }
        for (int pn = (int)blockIdx.x; pn < NPROJ / 256; pn += F.G) {
            pg8::ThinAcc T; const int l0 = hw_lane();
            pg8::thin_gemm<false>(F.ws + WS_XN, F.ws + WS_WIN, D * 2, pn, [](int fr) { return RX + fr; }, F.wave, l0, T, 0);
            pg8::thin_epi_inproj(T, pn, F.wave, l0, E.Q, E.Kb, E.V, E.U, E.CB, E.rcos, E.rsin, E.kmax); }
        SEAM(1);
    }

    if (IN(2)) {
        float lam;
        { const int l0 = hw_lane(); const float a = F.in[5][l0] * F.in[6][l0], b2 = F.in[7][l0] * F.in[8][l0];
          lam = expf(wave_sum(a)) - expf(wave_sum(b2)) + LAM_INIT; }
        const att::Tensors T{(const att::bf16_t*)(F.ws + WS_Q), (const att::bf16_t*)(F.ws + WS_K), (const att::bf16_t*)(F.ws + WS_V), (att::bf16_t*)(F.ws + WS_XN), F.in[9], lam, (const float*)(ctl + CW_KMAX)};
        const int c = (int)blockIdx.x;
        float* const parts = (float*)(F.ws + WS_PART);
        REP(2) { for (int i = 0;; ++i) {
            int b, h, qrow0, nvalid, tb = 0, te = att::NTILE; float* part = nullptr;
            if (F.G == 256) {
                const int xcd = c & 7, ci = c >> 3;
                if (i < 8) { const int bh = xcd + 8 * (i >> 1); b = bh >> 2; h = bh & 3; qrow0 = b * SEQ + ((i & 1) * 32 + ci) * 128; nvalid = 128; }
                else if (i == 8 && ci < 4 * att::META_CHUNKS) { const int bh = xcd + 8 * (ci / att::META_CHUNKS), ch = ci % att::META_CHUNKS; b = bh >> 2; h = bh & 3; qrow0 = RMETA + NMETA * b; nvalid = NMETA;
                    att::meta_chunk(ch, tb, te); part = parts + (size_t)(bh * att::META_CHUNKS + ch) * 2 * att::PART_F32; }
                else break;
            } else {
                const long L = (long)i * F.G + c;
                if (L < 2048) { const int bh = (int)(L >> 6); b = bh >> 2; h = bh & 3; qrow0 = b * SEQ + (int)(L & 63) * 128; nvalid = 128; }
                else if (L < 2048 + 32 * att::META_CHUNKS) { const int j = (int)(L - 2048), bh = j / att::META_CHUNKS, ch = j % att::META_CHUNKS; b = bh >> 2; h = bh & 3; qrow0 = RMETA + NMETA * b; nvalid = NMETA;
                    att::meta_chunk(ch, tb, te); part = parts + (size_t)(bh * att::META_CHUNKS + ch) * 2 * att::PART_F32; }
                else break;
            }
            att::attn_unit<8>(T, b, h, qrow0, nvalid, tb, te, part, (ALAS char*)(F.lds + RING_OFF), F.wave);
        } REPBAR(2); }
        REP(20) { conv_rows(F); REPBAR(20); }
        if (IN(3)) xcd_barrier(bar);
        if (F.gw < 32) att::meta_combine(T, parts, F.gw, hw_lane());
        SEAM(2);
    }

    if (IN(3)) {
        pg8::Gemm g{(const pg8::bf16_t*)(F.ws + WS_XN), (const pg8::bf16_t*)(F.ws + WS_WOUT), D};
        pg8::StaticOrder S; S.init(RX / 256, D / 256, F.G, (int)blockIdx.x);
        pg8::EpiOutProj E{F.in[0], F.in[1], (pg8::bf16_t*)(F.ws + WS_H1B), (float*)(F.ws + WS_H1M)};
        pg8::RowIdentity AM;
        REP(3) { pg8::gemm_phase<pg8::EpiOutProj, pg8::StaticOrder, pg8::RowIdentity, true>(F.lds + RING_OFF, g, S, E, AM, F.wave); REPBAR(3); }
        for (int i = (int)blockIdx.x; i < BATCH * (D / 256); i += F.G) {
            pg8::ThinAcc T; const int l0 = hw_lane(), b = i >> 2, pn = i & 3;
            pg8::thin_gemm<false>(F.ws + WS_XN, F.ws + WS_WOUT, D * 2, pn, [b](int fr) { return RX + NMETA * b + fr; }, F.wave, l0, T, 0);
            pg8::thin_epi_outproj(T, b, pn, F.wave, l0, F.in[1], (float*)(F.ws + WS_H1M)); }
        SEAM(3);
    }

    if (IN(4)) { REP(4) { p4_norm_router(F); REPBAR(4); } SEAM(4); }

    if (IN(5)) { REP(5) { for (int job = (int)blockIdx.x; job < BATCH * NEXP; job += F.G) p5_topk(F, job); REPBAR(5); } SEAM(5); }

    if (IN(6)) {
        pg8::Gemm g{(const pg8::bf16_t*)(F.ws + WS_HN2), (const pg8::bf16_t*)(F.ws + WS_W1), D / 2};
        pg8::ExpertOrder S; S.init(16, F.G, (int)blockIdx.x);
        pg8::EpiSwiglu E{F.ws + WS_H};
        pg8::RowGather AM{(const int*)(F.ws + WS_IDX)};
        const bool thin_first_ = (((int)blockIdx.x >> 3) & 1) != 0;
        { const bool thin_pass_ = thin_first_;
        for (int i = (int)blockIdx.x; i < NEXP * 16 && thin_pass_; i += F.G) {
            const int e = (F.G == 256) ? 2 * (i & 7) + (i >> 7) : i >> 4, ct = (F.G == 256) ? (i >> 3) & 15 : i & 15;
            pg8::ThinAcc T; const int l0 = hw_lane(); const int* idx = (const int*)(F.ws + WS_IDX) + e * EPAD + 32 * 256;
            pg8::thin_gemm<true>(F.ws + WS_HN2, F.ws + WS_W1, D, e * 16 + ct, [idx](int fr) { return idx[fr]; }, F.wave, l0, T, pg8::EpiSwiglu::WSCALE);
            pg8::thin_epi_swiglu(T, e, ct, F.wave, l0, F.ws + WS_H); }
        }
        REP(6) { pg8::gemm_phase<pg8::EpiSwiglu, pg8::ExpertOrder, pg8::RowGather, true, true>(F.lds + RING_OFF, g, S, E, AM, F.wave); REPBAR(6); }
        { const bool thin_pass_ = !thin_first_;
        for (int i = (int)blockIdx.x; i < NEXP * 16 && thin_pass_; i += F.G) {
            const int e = (F.G == 256) ? 2 * (i & 7) + (i >> 7) : i >> 4, ct = (F.G == 256) ? (i >> 3) & 15 : i & 15;
            pg8::ThinAcc T; const int l0 = hw_lane(); const int* idx = (const int*)(F.ws + WS_IDX) + e * EPAD + 32 * 256;
            pg8::thin_gemm<true>(F.ws + WS_HN2, F.ws + WS_W1, D, e * 16 + ct, [idx](int fr) { return idx[fr]; }, F.wave, l0, T, pg8::EpiSwiglu::WSCALE);
            pg8::thin_epi_swiglu(T, e, ct, F.wave, l0, F.ws + WS_H); }
        }
        SEAM(6);
    }

    if (IN(7)) {
        pg8::Gemm g{(const pg8::bf16_t*)(F.ws + WS_H), (const pg8::bf16_t*)(F.ws + WS_W2), FF / 2};
        pg8::ExpertOrder S; S.init(4, F.G, (int)blockIdx.x);
        pg8::EpiDown E{F.ws + WS_Y, (const float*)(F.ws + WS_GATE)};
        pg8::RowIdentity AM;
        REP(7) { pg8::gemm_phase<pg8::EpiDown, pg8::ExpertOrder, pg8::RowIdentity, true, true>(F.lds + RING_OFF, g, S, E, AM, F.wave); REPBAR(7); }
        for (int i = (int)blockIdx.x; i < NEXP * 4; i += F.G) {
            const int e = (F.G == 256) ? 2 * (i & 7) + (i >> 5) : i >> 2, ct = (F.G == 256) ? (i >> 3) & 3 : i & 3;
            pg8::ThinAcc T; const int l0 = hw_lane();
            pg8::thin_gemm<true>(F.ws + WS_H, F.ws + WS_W2, FF, e * 4 + ct, [e](int fr) { return e * EPAD + 32 * 256 + fr; }, F.wave, l0, T, pg8::EpiDown::WSCALE);
            pg8::thin_epi_down(T, e, ct, F.wave, l0, F.ws + WS_Y, (const float*)(F.ws + WS_GATE)); }
        SEAM(7);
    }

    if (IN(8)) { p8_final(F); }
#undef IN
#undef SEAM
}

extern "C" void kernel_launch(void* const* d_in, const int* in_sizes, int n_in, void* d_out, int out_size, void* d_ws, size_t ws_size, hipStream_t stream) {
    static int grid = 0;
    if (grid == 0) {
        if (n_in != 17 || out_size != RX * D || ws_size < WS_END) { fprintf(stderr, "kernel_launch: unexpected shapes (n_in %d, out %d, ws %zu < %zu)\n", n_in, out_size, ws_size, (size_t)WS_END); grid = -1; return; }
        int dev = 0, cus = 0, per_cu = 0;
        if (hipGetDevice(&dev) != hipSuccess || hipDeviceGetAttribute(&cus, hipDeviceAttributeMultiprocessorCount, dev) != hipSuccess) { grid = -1; return; }
        if (hipFuncSetAttribute((const void*)hymba_fwd, hipFuncAttributeMaxDynamicSharedMemorySize, LDS_BYTES) != hipSuccess) { fprintf(stderr, "kernel_launch: hipFuncSetAttribute failed\n"); grid = -1; return; }
        if (hipOccupancyMaxActiveBlocksPerMultiprocessor(&per_cu, (const void*)hymba_fwd, NWAVES * 64, LDS_BYTES) != hipSuccess || per_cu < 1) { fprintf(stderr, "kernel_launch: occupancy query says %d\n", per_cu); }
        (void)hipGetLastError();
        grid = cus;
    }
    if (grid < 0) return;
    (void)in_sizes;
    if (hipMemsetAsync((char*)d_ws + WS_CTL, 0, CTL_ZERO_BYTES, stream) != hipSuccess) return;
    Args a{};
    for (int i = 0; i < 17; ++i) a.in[i] = (const float*)d_in[i];
    a.out = (float*)d_out; a.ws = (unsigned char*)d_ws;
    if (MK_N_LAUNCHES == 1) { a.ph_lo = 0; a.ph_hi = N_PHASES; hipLaunchKernelGGL(hymba_fwd, dim3(grid), dim3(NWAVES * 64), LDS_BYTES, stream, a); }
    else for (int p = 0; p < N_PHASES; ++p) { a.ph_lo = p; a.ph_hi = p + 1; hipLaunchKernelGGL(hymba_fwd, dim3(grid), dim3(NWAVES * 64), LDS_BYTES, stream, a); }
}
```

```cpp
#include <hip/hip_runtime.h>
#include <cstdio>
#include <cstdint>
#include <cmath>
__device__ __forceinline__ int hw_lane() { int l; asm volatile("v_mbcnt_lo_u32_b32 %0, -1, 0\n\tv_mbcnt_hi_u32_b32 %0, -1, %0" : "=v"(l)); return l; }
namespace pg8 {
#define PG8_LAS __attribute__((address_space(3)))
typedef unsigned short bf16_t;
typedef short bf16x8 __attribute__((ext_vector_type(8)));
typedef float f32x4 __attribute__((ext_vector_type(4)));
typedef unsigned u32x4 __attribute__((ext_vector_type(4)));
typedef int v4i_t __attribute__((ext_vector_type(4)));
typedef int v8i_t __attribute__((ext_vector_type(8)));
constexpr int BM = 256, BK = 64, HALF = 128, HTB = HALF * BK * 2  , STAGE_BYTES = 8 * HTB, NXCD = 8, WGM = 4;

__host__ __device__ __forceinline__ int lds_byte(int r, int c) { const int st = (r >> 4) * 2 + (c >> 5), rr = r & 15, cc = c & 31, ob = rr * 64 + cc * 2; return st * 1024 + (ob ^ (((ob >> 9) & 1) << 5)); }
__host__ __device__ __forceinline__ void stage_rc(int b, int& R, int& C) { const int st = b / 1024, sb = b % 1024, swz = sb ^ (((sb >> 9) & 1) << 5); R = (st >> 1) * 16 + swz / 64; C = (st & 1) * 32 + (swz % 64) / 2; }
__host__ __device__ __forceinline__ int perm32(int rho) { const int n = rho >> 4, i = rho & 15; return 8 * (i >> 2) + 4 * n + (i & 3); }

struct Unit { int pm, pn; };
struct Gemm { const bf16_t* A; const bf16_t* Bt; int K; };

struct StaticOrder {
    int nM, nN, nwg, G, c;
    __host__ __device__ void init(int nM_, int nN_, int G_, int c_) { nM = nM_; nN = nN_; nwg = nM * nN; G = G_; c = c_; }
    __host__ __device__ bool next(int i, Unit& u) const {
        const long L = (long)i * G + c; if (L >= nwg) return false;
        int wgid = (int)L; { const int q = nwg / NXCD, r = nwg % NXCD, xcd = wgid % NXCD, off = wgid / NXCD; wgid = (xcd < r ? xcd * (q + 1) : r * (q + 1) + (xcd - r) * q) + off; }
        const int nig = WGM * nN, gid = wgid / nig, fm = gid * WGM, gsz = (nM - fm) < WGM ? (nM - fm) : WGM;
        u.pm = fm + ((wgid % nig) % gsz); u.pn = (wgid % nig) / gsz; return true;
    }
};
struct ExpertOrder {
    int NT, G, c;
    __host__ __device__ void init(int NT_, int G_, int c_) { NT = NT_; G = G_; c = c_; }
    __host__ __device__ bool next(int i, Unit& u) const {
        const int per = 32 * NT;
        int e, jj;
        if (G == 256) { const int xcd = c & 7, ci = c >> 3, j = i * 32 + ci; if (j >= 2 * per) return false; e = 2 * xcd + j / per; jj = j % per; }
        else { const long L = (long)i * G + c; if (L >= 16L * per) return false; e = (int)(L / per); jj = (int)(L % per); }
        const int blk = 8 * NT, rgp = jj / blk, w = jj % blk, cg = w >> 5, v = w & 31; const int rt = 8 * rgp + (v & 7), ct = cg * 4 + (v >> 3);
        u.pm = e * 33 + rt; u.pn = e * NT + ct; return true;
    }
};
struct RowIdentity { __device__ __forceinline__ unsigned row(int pm, int h, int R) const { return (unsigned)(pm * BM + h * HALF + R); } };
struct RowGather { const int* idx; __device__ __forceinline__ unsigned row(int pm, int h, int R) const { return (unsigned)idx[pm * BM + h * HALF + R]; } };

__device__ __forceinline__ unsigned cvt_pk_bf16(float lo, float hi) { unsigned r; asm volatile("v_cvt_pk_bf16_f32 %0, %1, %2" : "=v"(r) : "v"(lo), "v"(hi)); return r; }
__device__ __forceinline__ u32x4 pack8(const f32x4 v0, const f32x4 v1) { u32x4 w; w.x = cvt_pk_bf16(v0[0], v0[1]); w.y = cvt_pk_bf16(v0[2], v0[3]); w.z = cvt_pk_bf16(v1[0], v1[1]); w.w = cvt_pk_bf16(v1[2], v1[3]); return w; }


template <class Epi, class Sched, class AMap, bool ALIGN_EPI, bool FP8 = false>
__device__ __forceinline__ void gemm_phase(PG8_LAS unsigned char* lds, const Gemm g, const Sched& S, const Epi& E, const AMap& AM, const int wid) {
    const int lane = hw_lane(), tid = wid * 64 + lane, wr = wid >> 2, wc = wid & 3, fr = lane & 15, fq = lane >> 4;
    const int K = g.K, nt = K / BK;
    unsigned voffB[2];
#pragma unroll
    for (int i = 0; i < 2; ++i) { int R, C; stage_rc(tid * 16 + i * 8192, R, C); const int Rb = Epi::PERM ? ((R & ~31) + perm32(R & 31)) : R;
        voffB[i] = (unsigned)(Rb * K + C) * 2u; }
    const size_t kstep = (size_t)(BK * 2);
    const size_t hstep = (size_t)HALF * K * 2;
    const size_t tstep = 2 * hstep;
    const unsigned ldsw = (unsigned)wid * 1024u;
    const int aoff = lds_byte(wr * 64 + fr, fq * 8), boff = lds_byte(wc * 32 + fr, fq * 8);
#define PG8_SA(b, h) (((b) * 2 + (h)) * HTB)
#define PG8_SB(b, h) ((4 + (b) * 2 + (h)) * HTB)
#define PG8_STAGE(bufoff, gbase, voff) do { _Pragma("unroll") for (int _i = 0; _i < 2; ++_i) \
        __builtin_amdgcn_global_load_lds((const unsigned*)((const char*)(gbase) + (voff)[_i]), (PG8_LAS unsigned*)(lds + (bufoff) + ldsw + _i * 8192), 16, 0, 0); } while (0)
#define PG8_LD8(p) __builtin_shufflevector(*(const PG8_LAS v4i_t*)(p), *(const PG8_LAS v4i_t*)((p) + 1024), 0, 1, 2, 3, 4, 5, 6, 7)
#define PG8_LDA(dst, b, h) do { if constexpr (FP8) { _Pragma("unroll") for (int m = 0; m < 4; ++m) dst##8[m] = PG8_LD8(lds + PG8_SA(b, h) + aoff + m * 2048); } \
        else { _Pragma("unroll") for (int m = 0; m < 4; ++m) _Pragma("unroll") for (int k = 0; k < 2; ++k) dst[m][k] = *(const PG8_LAS bf16x8*)(lds + PG8_SA(b, h) + aoff + m * 2048 + k * 1024); } } while (0)
#define PG8_LDB(dst, b, h) do { if constexpr (FP8) { _Pragma("unroll") for (int n = 0; n < 2; ++n) dst##8[n] = PG8_LD8(lds + PG8_SB(b, h) + boff + n * 2048); } \
        else { _Pragma("unroll") for (int n = 0; n < 2; ++n) _Pragma("unroll") for (int k = 0; k < 2; ++k) dst[n][k] = *(const PG8_LAS bf16x8*)(lds + PG8_SB(b, h) + boff + n * 2048 + k * 1024); } } while (0)
#define PG8_MMA(ai, bj, At, Bt) do { __builtin_amdgcn_s_setprio(1); \
        if constexpr (FP8) { _Pragma("unroll") for (int m = 0; m < 4; ++m) _Pragma("unroll") for (int n = 0; n < 2; ++n) \
            asm volatile("v_mfma_scale_f32_16x16x128_f8f6f4 %0, %1, %2, %0, %3, %4 op_sel_hi:[0,0,0]" : "+v"(acc[ai][bj][m][n]) : "v"(Bt##8[n]), "v"(At##8[m]), "v"(wscale_), "v"(ascale_)); } \
        else { _Pragma("unroll") for (int m = 0; m < 4; ++m) _Pragma("unroll") for (int n = 0; n < 2; ++n) _Pragma("unroll") for (int k = 0; k < 2; ++k) \
            acc[ai][bj][m][n] = __builtin_amdgcn_mfma_f32_16x16x32_bf16(Bt[n][k], At[m][k], acc[ai][bj][m][n], 0, 0, 0); } \
        __builtin_amdgcn_s_setprio(0); } while (0)
#define PG8_WAIT_V(n) asm volatile("s_waitcnt vmcnt(" #n ")" ::: "memory")
#define PG8_WAIT_L(n) asm volatile("s_waitcnt lgkmcnt(" #n ")" ::: "memory")
#define PG8_BAR __builtin_amdgcn_s_barrier()
#define PG8_SCHED __builtin_amdgcn_sched_barrier(0)
#define PG8_ARAW(dst, u_) do { _Pragma("unroll") for (int _h = 0; _h < 2; ++_h) _Pragma("unroll") for (int _i = 0; _i < 2; ++_i) { int R_, C_; stage_rc(tid * 16 + _i * 8192, R_, C_); dst[_h][_i] = AM.row((u_).pm, _h, R_); } } while (0)
#define PG8_AOFS(dst, raw) do { _Pragma("unroll") for (int _h = 0; _h < 2; ++_h) _Pragma("unroll") for (int _i = 0; _i < 2; ++_i) { int R_, C_; stage_rc(tid * 16 + _i * 8192, R_, C_); dst[_h][_i] = (raw[_h][_i] * (unsigned)K + (unsigned)C_) * 2u; } } while (0)
    Unit cur, nxt; int ui = 0;
    if (!S.next(0, cur)) return;
    f32x4 acc[2][2][4][2];
#pragma unroll
    for (int a = 0; a < 2; ++a)
#pragma unroll
        for (int b = 0; b < 2; ++b)
#pragma unroll
            for (int m = 0; m < 4; ++m)
#pragma unroll
                for (int n = 0; n < 2; ++n) acc[a][b][m][n] = (f32x4){0.f, 0.f, 0.f, 0.f};
    const int wscale_ = Epi::WSCALE, ascale_ = 0x7f7f7f7f;
    bf16x8 At[4][2], B0[2][2], B1[2][2]; v8i_t At8[4], B08[2], B18[2];
    unsigned voA[2][2], rawN[2][2];
    PG8_ARAW(rawN, cur); PG8_AOFS(voA, rawN);
    const char* const Ab = (const char*)g.A;
    const char* cB = (const char*)g.Bt + (size_t)cur.pn * tstep;
    PG8_STAGE(PG8_SB(0, 0), cB, voffB); PG8_STAGE(PG8_SB(0, 1), cB + hstep, voffB); PG8_STAGE(PG8_SA(0, 0), Ab, voA[0]); PG8_STAGE(PG8_SA(0, 1), Ab, voA[1]);
    if (wr == 1) PG8_BAR;
    PG8_WAIT_V(2); PG8_BAR;
    PG8_STAGE(PG8_SB(1, 0), cB + kstep, voffB); PG8_STAGE(PG8_SA(1, 0), Ab + kstep, voA[0]); PG8_STAGE(PG8_SB(1, 1), cB + hstep + kstep, voffB);
    PG8_WAIT_V(6); PG8_BAR;
    for (;;) {
        const bool has_next = S.next(ui + 1, nxt);
        if (has_next) { PG8_ARAW(rawN, nxt); }
        const char* nB = has_next ? (const char*)g.Bt + (size_t)nxt.pn * tstep : cB;
#pragma unroll 1
        for (int t = 0; t < nt; t += 2) {
            const bool last = (t == nt - 2);
            const char* a1 = Ab + (size_t)(t + 1) * kstep;
            const char* a2 = last ? Ab : Ab + (size_t)(t + 2) * kstep; const char* b2 = last ? nB : cB + (size_t)(t + 2) * kstep;
            const char* a3 = a2 + kstep; const char* b3 = b2 + kstep;
            unsigned v2[2][2];
            if (last) { asm volatile("" ::: "memory"); PG8_AOFS(v2, rawN); }
            else {
#pragma unroll
                for (int _h = 0; _h < 2; ++_h)
#pragma unroll
                    for (int _i = 0; _i < 2; ++_i) v2[_h][_i] = voA[_h][_i]; }
            PG8_LDB(B0, 0, 0); PG8_LDB(B1, 0, 1); PG8_SCHED; PG8_LDA(At, 0, 0); PG8_STAGE(PG8_SA(1, 1), a1, voA[1]);
            PG8_WAIT_V(8); PG8_WAIT_L(0); PG8_BAR; PG8_MMA(0, 0, At, B0); PG8_MMA(0, 1, At, B1); PG8_BAR; PG8_SCHED;
            PG8_LDA(At, 0, 1); PG8_STAGE(PG8_SB(0, 0), b2, voffB); PG8_STAGE(PG8_SB(0, 1), b2 + hstep, voffB); PG8_STAGE(PG8_SA(0, 0), a2, v2[0]);
            PG8_WAIT_V(8); PG8_WAIT_L(0); PG8_BAR; PG8_MMA(1, 0, At, B0); PG8_MMA(1, 1, At, B1); PG8_BAR; PG8_SCHED;
            PG8_LDB(B0, 1, 0); PG8_LDB(B1, 1, 1); PG8_SCHED; PG8_LDA(At, 1, 0); PG8_STAGE(PG8_SA(0, 1), a2, v2[1]);
            PG8_WAIT_V(8); PG8_WAIT_L(0); PG8_BAR; PG8_MMA(0, 0, At, B0); PG8_MMA(0, 1, At, B1); PG8_BAR; PG8_SCHED;
            PG8_LDA(At, 1, 1); PG8_STAGE(PG8_SB(1, 0), b3, voffB); PG8_STAGE(PG8_SB(1, 1), b3 + hstep, voffB); PG8_STAGE(PG8_SA(1, 0), a3, v2[0]);
            PG8_WAIT_V(8); PG8_WAIT_L(0); PG8_BAR; PG8_MMA(1, 0, At, B0); PG8_MMA(1, 1, At, B1); PG8_BAR; PG8_SCHED;
        }
        if constexpr (ALIGN_EPI) { if (wr == 0) PG8_BAR; }
        if constexpr (FP8) asm volatile("s_nop 15\n\ts_nop 15" ::: "memory");
        E(acc, cur, wr, wc, fr, fq);
        if (!has_next) break;
#pragma unroll
        for (int a = 0; a < 2; ++a)
#pragma unroll
            for (int b = 0; b < 2; ++b)
#pragma unroll
                for (int m = 0; m < 4; ++m)
#pragma unroll
                    for (int n = 0; n < 2; ++n) acc[a][b][m][n] = (f32x4){0.f, 0.f, 0.f, 0.f};
        cur = nxt; cB = nB; ++ui;
        PG8_AOFS(voA, rawN);
        if constexpr (ALIGN_EPI) { if (wr == 1) PG8_BAR; }
    }
    PG8_WAIT_V(0);
    if constexpr (!ALIGN_EPI) { if (wr == 0) PG8_BAR; }
    PG8_BAR;
#undef PG8_SA
#undef PG8_SB
#undef PG8_STAGE
#undef PG8_LDA
#undef PG8_LDB
#undef PG8_MMA
#undef PG8_LD8
#undef PG8_WAIT_V
#undef PG8_WAIT_L
#undef PG8_BAR
#undef PG8_SCHED
#undef PG8_ARAW
#undef PG8_AOFS
}
}
constexpr int D = 1024, BATCH = 8, SEQ = 8192, NMETA = 16, LSEQ = SEQ + NMETA;
constexpr int RX = BATCH * SEQ;
constexpr int RMETA = RX;
constexpr int RV = RX + BATCH * NMETA;
constexpr int RP = 257 * 256;
constexpr int AW = 512, CWID = 512, NPROJ = 3072;
constexpr int NEXP = 16, CAP = 1026, FF = 2048;
constexpr int EROWS = BATCH * CAP;
constexpr int EPAD = 33 * 256;
constexpr int KV_TILES = 129;
constexpr float NORM_EPS = 1e-6f;
constexpr float LAM_INIT = 0.2f;
constexpr float C2 = 0.125f * 1.4426950408889634f;

namespace pg8 {
template <bool SKIP = false> struct EpiInProjT {
    static constexpr bool PERM = true; static constexpr int WSCALE = 0x7f7f7f7f;
    bf16_t *Q, *Kb, *V, *U, *CB; const float* rcos; const float* rsin;
    unsigned* kmax;
    __device__ __forceinline__ void operator()(const f32x4 (&acc)[2][2][4][2], const Unit& u_in, int wr, int wc, int fr_, int fq_) const {
        const int l_ = hw_lane(), fr = l_ & 15, fq = l_ >> 4; (void)fr_; (void)fq_;
        const Unit& u = u_in;
        const int row0 = u.pm * BM + wr * 64 + fr; const int pn = u.pn;
        const bool xt = u.pm < RX / BM;
        if (pn < 4) {
            const int sh = (pn & 1) * 4 + wc;
            const float* rc0 = rcos + (xt ? NMETA + (u.pm & 31) * 256 + wr * 64 + fr : fr) * 32 + 8 * fq; const float* rs0 = rc0 + (rsin - rcos);
            const float sc = pn < 2 ? C2 : 1.0f;
            bf16_t* p0; int st_ai, st_m;
            if (pn < 2) { p0 = Q + (size_t)row0 * AW + sh * 64 + 8 * fq; st_ai = HALF * AW; st_m = 16 * AW; }
            else if (xt) { p0 = Kb + ((size_t)(((u.pm >> 5) * 8 + sh) * KV_TILES + 1 + (u.pm & 31) * 4 + wr)) * 4096 + fq * 512 + (16 * (fr >> 2) + 4 * ((fr >> 1) & 1) + 8 * (fr & 1)) * 8; st_ai = 2 * 4096; st_m = 8; }
            else { p0 = Kb + ((size_t)((wr * 4 * 8 + sh) * KV_TILES)) * 4096 + fq * 512 + fr * 8; st_ai = 0; st_m = 8 * KV_TILES * 4096; }
            const int o2 = pn < 2 ? 32 : 2048;
            f32x4 cb0 = *(const f32x4*)rc0, cb1 = *(const f32x4*)(rc0 + 4), sb0 = *(const f32x4*)rs0, sb1 = *(const f32x4*)(rs0 + 4);
            f32x4 cA0 = (f32x4){1.f, 1.f, 1.f, 1.f}, cA1 = cA0, sA0 = (f32x4){0.f, 0.f, 0.f, 0.f}, sA1 = sA0;
            if (xt) { cA0 = *(const f32x4*)(rcos + 16 * 32 + 8 * fq); cA1 = *(const f32x4*)(rcos + 16 * 32 + 8 * fq + 4); sA0 = *(const f32x4*)(rsin + 16 * 32 + 8 * fq); sA1 = *(const f32x4*)(rsin + 16 * 32 + 8 * fq + 4); }
            float ksq = 0.f;
#pragma unroll
            for (int ai = 0; ai < 2; ++ai) {
                if (!xt && ai == 1 && pn >= 2) break;
                f32x4 c0 = cb0, c1 = cb1, s0 = sb0, s1 = sb1;
#pragma unroll
                for (int m = 0; m < 4; ++m) {
                    const f32x4 x10 = acc[ai][0][m][0], x11 = acc[ai][0][m][1], x20 = acc[ai][1][m][0], x21 = acc[ai][1][m][1];
                    const f32x4 a0 = (x10 * c0 - x20 * s0) * sc, a1 = (x11 * c1 - x21 * s1) * sc, b0 = (x20 * c0 + x10 * s0) * sc, b1 = (x21 * c1 + x11 * s1) * sc;
                    bf16_t* p = p0 + (size_t)ai * st_ai + (size_t)m * st_m;
                    *(u32x4*)p = pack8(a0, a1); *(u32x4*)(p + o2) = pack8(b0, b1);
                    if (pn >= 2) { const f32x4 q_ = a0 * a0 + a1 * a1 + b0 * b0 + b1 * b1; float ps_ = (q_[0] + q_[1]) + (q_[2] + q_[3]);
                        ps_ += __shfl_xor(ps_, 16); ps_ += __shfl_xor(ps_, 32); ksq = fmaxf(ksq, ps_); }
                    if (m < 3) { const f32x4 n0 = c0 * cA0 - s0 * sA0, n1 = c1 * cA1 - s1 * sA1; s0 = s0 * cA0 + c0 * sA0; s1 = s1 * cA1 + c1 * sA1; c0 = n0; c1 = n1; } }
                if (ai == 0 && xt) { const f32x4 cB0 = *(const f32x4*)(rcos + 128 * 32 + 8 * fq), cB1 = *(const f32x4*)(rcos + 128 * 32 + 8 * fq + 4), sB0 = *(const f32x4*)(rsin + 128 * 32 + 8 * fq), sB1 = *(const f32x4*)(rsin + 128 * 32 + 8 * fq + 4);
                    const f32x4 n0 = cb0 * cB0 - sb0 * sB0, n1 = cb1 * cB1 - sb1 * sB1; sb0 = sb0 * cB0 + cb0 * sB0; sb1 = sb1 * cB1 + cb1 * sB1; cb0 = n0; cb1 = n1; }
            }
            if (pn >= 2 && xt) {
#pragma unroll
                for (int m_ = 1; m_ < 16; m_ <<= 1) ksq = fmaxf(ksq, __shfl_xor(ksq, m_));
                if (l_ == 0) { const unsigned old_ = __hip_atomic_fetch_max(kmax + (u.pm >> 5) * 8 + sh, __float_as_uint(ksq * 1.02f), __ATOMIC_RELAXED, __HIP_MEMORY_SCOPE_AGENT); asm volatile("" :: "v"(old_)); } }
        } else if (pn < 6) {
            if (xt) {
                unsigned char* p0 = (unsigned char*)V + ((size_t)(((u.pm >> 5) * 4 + (pn - 4) * 2) * KV_TILES + 1 + (u.pm & 31) * 4 + wr)) * 8192 + wc * 2048
                                    + ((fr >> 1) & 1) * 1024 + (fr >> 3) * 512 + fq * 128 + (2 * ((fr >> 2) & 1) + (fr & 1)) * 4;
#pragma unroll
                for (int ai = 0; ai < 2; ++ai)
#pragma unroll
                    for (int bj = 0; bj < 2; ++bj)
#pragma unroll
                        for (int n = 0; n < 2; ++n)
#pragma unroll
                            for (int i = 0; i < 4; ++i) { int w_ = __builtin_amdgcn_cvt_pk_fp8_f32(16.f * acc[ai][bj][0][n][i], 16.f * acc[ai][bj][1][n][i], 0, false);
                                w_ = __builtin_amdgcn_cvt_pk_fp8_f32(16.f * acc[ai][bj][2][n][i], 16.f * acc[ai][bj][3][n][i], w_, true);
                                *(int*)(p0 + (size_t)ai * (2 * 8192) + (size_t)bj * KV_TILES * 8192 + (4 * n + i) * 16) = w_; }
            }
        } else if (pn < 10) {
            const int colb = (pn - 6) * 128 + wc * 32 + 8 * fq;
#pragma unroll
            for (int ai = 0; ai < 2; ++ai)
#pragma unroll
                for (int m = 0; m < 4; ++m) { bf16_t* p = U + (size_t)(row0 + ai * HALF + m * 16) * CWID + colb;
                    *(u32x4*)p = pack8(acc[ai][0][m][0] * acc[ai][1][m][0], acc[ai][0][m][1] * acc[ai][1][m][1]); }
        } else {
            const int colb = (pn - 10) * 256 + wc * 32 + 8 * fq;
#pragma unroll
            for (int ai = 0; ai < 2; ++ai)
#pragma unroll
                for (int m = 0; m < 4; ++m) { bf16_t* p = CB + (size_t)(row0 + ai * HALF + m * 16) * CWID + colb;
#pragma unroll
                    for (int bj = 0; bj < 2; ++bj) *(u32x4*)(p + bj * HALF) = pack8(acc[ai][bj][m][0], acc[ai][bj][m][1]); }
        }
    }
};
typedef EpiInProjT<false> EpiInProj;
struct EpiOutProj {
    static constexpr bool PERM = true; static constexpr int WSCALE = 0x7f7f7f7f;
    const float* x; const float* meta; bf16_t* h1b; float* h1meta;
    __device__ __forceinline__ void operator()(const f32x4 (&acc)[2][2][4][2], const Unit& u, int wr, int wc, int fr, int fq) const {
        const int col0 = u.pn * BM + wc * 32 + 8 * fq;
        if (u.pm < RX / BM) {
#pragma unroll
            for (int ai = 0; ai < 2; ++ai)
#pragma unroll
                for (int m = 0; m < 4; ++m) { const size_t off = (size_t)(u.pm * BM + ai * HALF + wr * 64 + m * 16 + fr) * D + col0;
#pragma unroll
                    for (int bj = 0; bj < 2; ++bj) { const f32x4 b0 = *(const f32x4*)(x + off + bj * HALF), b1 = *(const f32x4*)(x + off + bj * HALF + 4);
                        *(u32x4*)(h1b + off + bj * HALF) = pack8(b0 + acc[ai][bj][m][0], b1 + acc[ai][bj][m][1]); } }
        } else {
#pragma unroll
            for (int m = 0; m < 4; ++m) { const int rr = wr * 64 + m * 16 + fr; const size_t off = (size_t)rr * D + col0; const size_t moff = (size_t)(rr & (NMETA - 1)) * D + col0;
#pragma unroll
                for (int bj = 0; bj < 2; ++bj)
#pragma unroll
                    for (int n = 0; n < 2; ++n) { const f32x4 bs = *(const f32x4*)(meta + moff + bj * HALF + n * 4); *(f32x4*)(h1meta + off + bj * HALF + n * 4) = bs + acc[0][bj][m][n]; } }
        }
    }
};
__device__ __forceinline__ unsigned pack4_fp8(const f32x4 v) { int w = __builtin_amdgcn_cvt_pk_fp8_f32(v[0], v[1], 0, false); w = __builtin_amdgcn_cvt_pk_fp8_f32(v[2], v[3], w, true); return (unsigned)w; }
struct EpiSwiglu {
    static constexpr bool PERM = true; static constexpr int WSCALE = 0x79797979;
    unsigned char* H;
    __device__ __forceinline__ void operator()(const f32x4 (&acc)[2][2][4][2], const Unit& u, int wr, int wc, int fr, int fq) const {
        typedef unsigned u32x2 __attribute__((ext_vector_type(2)));
        const int colb = (u.pn & 15) * 128 + wc * 32 + 8 * fq;
#pragma unroll
        for (int ai = 0; ai < 2; ++ai)
#pragma unroll
            for (int m = 0; m < 4; ++m) { f32x4 h[2];
#pragma unroll
                for (int n = 0; n < 2; ++n) { const f32x4 a = acc[ai][0][m][n], b = acc[ai][1][m][n];
#pragma unroll
                    for (int i = 0; i < 4; ++i) h[n][i] = a[i] * __builtin_amdgcn_rcpf(1.0f + __builtin_amdgcn_exp2f(-1.4426950408889634f * a[i])) * b[i]; }
                *(u32x2*)(H + (size_t)(u.pm * BM + ai * HALF + wr * 64 + m * 16 + fr) * FF + colb) = (u32x2){pack4_fp8(h[0]), pack4_fp8(h[1])}; }
    }
};
struct EpiDown {
    static constexpr bool PERM = true; static constexpr int WSCALE = 0x79797979;
    unsigned char* Y; const float* gate;
    __device__ __forceinline__ void operator()(const f32x4 (&acc)[2][2][4][2], const Unit& u, int wr, int wc, int fr, int fq) const {
        typedef unsigned u32x2 __attribute__((ext_vector_type(2)));
        const int colb = (u.pn & 3) * 256 + wc * 32 + 8 * fq;
#pragma unroll
        for (int ai = 0; ai < 2; ++ai)
#pragma unroll
            for (int m = 0; m < 4; ++m) { const int r = u.pm * BM + ai * HALF + wr * 64 + m * 16 + fr; const float gv = gate[r] * 16.0f;
#pragma unroll
                for (int bj = 0; bj < 2; ++bj) *(u32x2*)(Y + (size_t)r * D + colb + bj * HALF) = (u32x2){pack4_fp8(acc[ai][bj][m][0] * gv), pack4_fp8(acc[ai][bj][m][1] * gv)}; }
    }
};
}
namespace pg8 {
struct ThinAcc { f32x4 v[2]; };
template <bool FP8, class RowF>
__device__ __forceinline__ void thin_gemm(const unsigned char* A, const unsigned char* Bt, int Kb  , int pn_flat, const RowF& rowf, int wid, int lane, ThinAcc& T, int wscale) {
    const int fr = lane & 15, kq = lane >> 4, wc = wid & 3, n = wid >> 2;
    const unsigned char* ap = A + (size_t)rowf(fr) * Kb;
    const int bcol = 32 * wc + 8 * (fr >> 2) + 4 * n + (fr & 3);
    const unsigned char* bp0 = Bt + ((size_t)pn_flat * BM + bcol) * Kb, * bp1 = bp0 + (size_t)HALF * Kb;
    T.v[0] = (f32x4){0.f, 0.f, 0.f, 0.f}; T.v[1] = T.v[0];
    if constexpr (FP8) {
        const int ascale = 0x7f7f7f7f;
#pragma unroll 4
        for (int s = 0; s < Kb / 128; ++s) { const int o = s * 128 + kq * 32;
            const v4i_t a0 = *(const v4i_t*)(ap + o), a1 = *(const v4i_t*)(ap + o + 16), b00 = *(const v4i_t*)(bp0 + o), b01 = *(const v4i_t*)(bp0 + o + 16), b10 = *(const v4i_t*)(bp1 + o), b11 = *(const v4i_t*)(bp1 + o + 16);
            const v8i_t a8 = __builtin_shufflevector(a0, a1, 0, 1, 2, 3, 4, 5, 6, 7), b08 = __builtin_shufflevector(b00, b01, 0, 1, 2, 3, 4, 5, 6, 7), b18 = __builtin_shufflevector(b10, b11, 0, 1, 2, 3, 4, 5, 6, 7);
            T.v[0] = __builtin_amdgcn_mfma_scale_f32_16x16x128_f8f6f4(b08, a8, T.v[0], 0, 0, 0, wscale, 0, ascale);
            T.v[1] = __builtin_amdgcn_mfma_scale_f32_16x16x128_f8f6f4(b18, a8, T.v[1], 0, 0, 0, wscale, 0, ascale); }
    } else {
#pragma unroll 8
        for (int s = 0; s < Kb / 64; ++s) { const int o = s * 64 + kq * 16;
            const bf16x8 a = *(const bf16x8*)(ap + o), b0 = *(const bf16x8*)(bp0 + o), b1 = *(const bf16x8*)(bp1 + o);
            T.v[0] = __builtin_amdgcn_mfma_f32_16x16x32_bf16(b0, a, T.v[0], 0, 0, 0);
            T.v[1] = __builtin_amdgcn_mfma_f32_16x16x32_bf16(b1, a, T.v[1], 0, 0, 0); }
    }
}
typedef unsigned u32x2 __attribute__((ext_vector_type(2)));
__device__ __forceinline__ u32x2 pack4(const f32x4 v) { return (u32x2){cvt_pk_bf16(v[0], v[1]), cvt_pk_bf16(v[2], v[3])}; }
__device__ __forceinline__ void thin_epi_inproj(const ThinAcc& T, int pn, int wid, int lane, bf16_t* Q, bf16_t* Kb, bf16_t* V, bf16_t* U, bf16_t* CB, const float* rcos, const float* rsin, unsigned* kmax) {
    const int fr = lane & 15, fq = lane >> 4, wc = wid & 3, n = wid >> 2, c8 = 8 * fq + 4 * n;
    if (pn < 4) {
        const int sh = (pn & 1) * 4 + wc; const float sc = pn < 2 ? C2 : 1.0f;
        const f32x4 c = *(const f32x4*)(rcos + fr * 32 + c8), s = *(const f32x4*)(rsin + fr * 32 + c8);
        const f32x4 r1 = (T.v[0] * c - T.v[1] * s) * sc, r2 = (T.v[1] * c + T.v[0] * s) * sc;
        const u32x2 o1 = pack4(r1), o2 = pack4(r2);
        if (pn >= 2) {
            const f32x4 q_ = r1 * r1 + r2 * r2; float ps_ = (q_[0] + q_[1]) + (q_[2] + q_[3]); ps_ += __shfl_xor(ps_, 16); ps_ += __shfl_xor(ps_, 32);
#pragma unroll
            for (int m_ = 1; m_ < 16; m_ <<= 1) ps_ = fmaxf(ps_, __shfl_xor(ps_, m_));
            if (lane == 0) for (int b = 0; b < BATCH; ++b) { const unsigned old_ = __hip_atomic_fetch_max(kmax + b * 8 + sh, __float_as_uint(ps_ * 2.04f), __ATOMIC_RELAXED, __HIP_MEMORY_SCOPE_AGENT); asm volatile("" :: "v"(old_)); } }
        for (int b = 0; b < BATCH; ++b) {
            if (pn < 2) { bf16_t* p = Q + (size_t)(RX + NMETA * b + fr) * AW + sh * 64 + c8; *(u32x2*)p = o1; *(u32x2*)(p + 32) = o2; }
            else { bf16_t* p = Kb + ((size_t)((b * 8 + sh) * KV_TILES)) * 4096 + fq * 512 + fr * 8 + 4 * n; *(u32x2*)p = o1; *(u32x2*)(p + 2048) = o2; } }
    } else if (pn < 6) {
        for (int b = 0; b < BATCH; ++b)
#pragma unroll
            for (int bj = 0; bj < 2; ++bj) {
                const unsigned w = pack4_fp8(T.v[bj] * 16.0f);
                unsigned char* p = (unsigned char*)V + ((size_t)((b * 4 + (pn - 4) * 2 + bj) * KV_TILES)) * 8192 + wc * 2048 + ((fr >> 2) & 1) * 1024 + c8 * 16 + (fr >> 3) * 4 + (fr & 3);
                p[0] = (unsigned char)(w & 0xffu); p[16] = (unsigned char)((w >> 8) & 0xffu); p[32] = (unsigned char)((w >> 16) & 0xffu); p[48] = (unsigned char)(w >> 24); }
    } else if (pn < 10) {
        const u32x2 o = pack4(T.v[0] * T.v[1]);
        for (int b = 0; b < BATCH; ++b) *(u32x2*)(U + (size_t)(RX + NMETA * b + fr) * CWID + (pn - 6) * 128 + wc * 32 + c8) = o;
    } else {
        for (int b = 0; b < BATCH; ++b)
#pragma unroll
            for (int bj = 0; bj < 2; ++bj) *(u32x2*)(CB + (size_t)(RX + NMETA * b + fr) * CWID + (pn - 10) * 256 + bj * HALF + wc * 32 + c8) = pack4(T.v[bj]);
    }
}
__device__ __forceinline__ void thin_epi_outproj(const ThinAcc& T, int b, int pn, int wid, int lane, const float* meta, float* h1meta) {
    const int fr = lane & 15, fq = lane >> 4, wc = wid & 3, n = wid >> 2;
#pragma unroll
    for (int bj = 0; bj < 2; ++bj) { const int col = pn * BM + bj * HALF + wc * 32 + 8 * fq + 4 * n;
        *(f32x4*)(h1meta + (size_t)(NMETA * b + fr) * D + col) = *(const f32x4*)(meta + (size_t)fr * D + col) + T.v[bj]; }
}
__device__ __forceinline__ void thin_epi_swiglu(const ThinAcc& T, int e, int ct, int wid, int lane, unsigned char* H) {
    const int fr = lane & 15, fq = lane >> 4, wc = wid & 3, n = wid >> 2; f32x4 h;
#pragma unroll
    for (int i = 0; i < 4; ++i) { const float a = T.v[0][i]; h[i] = a * __builtin_amdgcn_rcpf(1.0f + __builtin_amdgcn_exp2f(-1.4426950408889634f * a)) * T.v[1][i]; }
    *(unsigned*)(H + (size_t)(e * EPAD + 32 * BM + fr) * FF + ct * 128 + wc * 32 + 8 * fq + 4 * n) = pack4_fp8(h);
}
__device__ __forceinline__ void thin_epi_down(const ThinAcc& T, int e, int ct, int wid, int lane, unsigned char* Y, const float* gate) {
    const int fr = lane & 15, fq = lane >> 4, wc = wid & 3, n = wid >> 2; const int r = e * EPAD + 32 * BM + fr; const float gv = gate[r] * 16.0f;
#pragma unroll
    for (int bj = 0; bj < 2; ++bj) *(unsigned*)(Y + (size_t)r * D + ct * 256 + bj * HALF + wc * 32 + 8 * fq + 4 * n) = pack4_fp8(T.v[bj] * gv);
}
}
constexpr size_t al256(size_t x) { return (x + 255) & ~(size_t)255; }
constexpr size_t WS_CTL = 0, CTL_ZERO_BYTES = 65536;
constexpr size_t WS_ROPE = WS_CTL + CTL_ZERO_BYTES;
constexpr size_t SZ_ROPE = al256((size_t)LSEQ * 32 * 4 * 2);
constexpr size_t WS_AFF = WS_ROPE + SZ_ROPE;
constexpr size_t SZ_AFF = al256((size_t)BATCH * NEXP * LSEQ * 4);
constexpr size_t WS_IDX = WS_AFF + SZ_AFF;
constexpr size_t SZ_IDX = al256((size_t)NEXP * EPAD * 4);
constexpr size_t WS_GATE = WS_IDX + SZ_IDX;
constexpr size_t WS_INV = WS_GATE + SZ_IDX;
constexpr size_t SZ_INV = al256((size_t)RV * NEXP * 4);
constexpr size_t WS_PART = WS_INV + SZ_INV;
constexpr size_t SZ_PART = al256((size_t)32 * 7 * 2 * (64 + 4 * 8 * 64) * 4);
constexpr size_t WS_RTAB = WS_PART + SZ_PART;
constexpr size_t SZ_RTAB = al256((size_t)2 * 16 * 1032 * 2 + 1024 * 4);
constexpr size_t WS_H1M = WS_RTAB + SZ_RTAB;
constexpr size_t SZ_H1M = (size_t)BATCH * NMETA * D * 4;
constexpr size_t WS_WIN = al256(WS_H1M + SZ_H1M);
constexpr size_t SZ_WIN = (size_t)NPROJ * D * 2;
constexpr size_t WS_WOUT = WS_WIN + SZ_WIN;
constexpr size_t SZ_WOUT = (size_t)D * D * 2;
constexpr size_t WS_Q = WS_WOUT + SZ_WOUT;
constexpr size_t SZ_QKV = (size_t)RP * AW * 2;
constexpr size_t SZ_KIMG = (size_t)BATCH * 8 * KV_TILES * 8192;
constexpr size_t WS_K = WS_Q + SZ_QKV;
constexpr size_t WS_W1 = WS_K + SZ_KIMG;
constexpr size_t SZ_W1 = (size_t)NEXP * 2 * FF * D * 2;
constexpr size_t WS_Y = WS_WIN;
constexpr size_t SZ_Y = (size_t)NEXP * EPAD * D * 2;
static_assert(WS_W1 + SZ_W1 - WS_Y >= SZ_Y, "Y overlay fits");
constexpr size_t WS_W2 = WS_W1 + SZ_W1;
constexpr size_t SZ_W2 = (size_t)NEXP * D * FF * 2;
constexpr size_t WS_XN = WS_W2 + SZ_W2;
constexpr size_t SZ_XN = (size_t)RP * D * 2;
constexpr size_t WS_V = WS_XN + SZ_XN, WS_U = WS_V + SZ_KIMG, WS_CB = WS_U + SZ_QKV;
constexpr size_t WS_H = WS_XN;
constexpr size_t SZ_H = (size_t)NEXP * EPAD * FF * 2;
constexpr size_t SZ_H8 = (size_t)NEXP * EPAD * FF;
constexpr size_t WS_H1B = WS_H + SZ_H8;
constexpr size_t WS_HN2 = WS_H1B + (size_t)RX * D * 2;
constexpr size_t WS_END = WS_H + SZ_H;
static_assert(WS_HN2 + (size_t)RP * D <= WS_END, "H | H1B | HN2 fit in the H region");
static_assert(WS_CB + SZ_QKV <= WS_END, "H region covers XN, V, U, CB");
static_assert(WS_END <= (size_t)1 << 30, "workspace map fits in 1 GiB");
constexpr int CW_BAR = 1024;
constexpr int CW_KMAX = 8192;

constexpr int RING_OFF = 0, RING_BYTES = 131072;
constexpr int LDS_BYTES = 163840;
constexpr int MISC_OFF = LDS_BYTES - 256;

#define GAS __attribute__((address_space(1)))
#define LAS __attribute__((address_space(3)))
typedef unsigned short bf16;
typedef unsigned v4u __attribute__((ext_vector_type(4)));
typedef unsigned v2u __attribute__((ext_vector_type(2)));
typedef float f32x4 __attribute__((ext_vector_type(4)));
#define LDS_WAIT() asm volatile("s_waitcnt lgkmcnt(0)" ::: "memory")
#define VM_WAIT() asm volatile("s_waitcnt vmcnt(0)" ::: "memory")
__device__ __forceinline__ unsigned pk2(float lo, float hi) { return pg8::cvt_pk_bf16(lo, hi); }
__device__ __forceinline__ float bf_lo(unsigned w) { return __uint_as_float(w << 16); }
__device__ __forceinline__ float bf_hi(unsigned w) { return __uint_as_float(w & 0xffff0000u); }
__device__ __forceinline__ float wave_sum(float v) {
#pragma unroll
    for (int o = 1; o < 64; o <<= 1) v += __shfl_xor(v, o);
    return v;
}
namespace att {
#define ALAS __attribute__((address_space(3)))
typedef unsigned short bf16_t;
typedef short bf16x8 __attribute__((ext_vector_type(8)));
typedef short s16x4 __attribute__((ext_vector_type(4)));
typedef float f32x16 __attribute__((ext_vector_type(16)));
typedef unsigned u32x4 __attribute__((ext_vector_type(4)));
typedef int i32x4 __attribute__((ext_vector_type(4)));
typedef int i32x8 __attribute__((ext_vector_type(8)));
typedef float f32x4_t __attribute__((ext_vector_type(4)));
constexpr int KT = 64, NTILE = 129, SLOT = 16384;
constexpr int OFF_K = 0, OFF_V = 3 * SLOT, OFF_WS = 6 * SLOT, OFF_ONES = OFF_WS + 8 * 256, LDS_BYTES = OFF_ONES + 2048;
__device__ __forceinline__ int crow(int r, int hi) { return (r & 3) + 8 * (r >> 2) + 4 * hi; }
__device__ __forceinline__ unsigned cvtpk(float lo, float hi) { typedef float f32x2_t __attribute__((ext_vector_type(2))); typedef __bf16 bf16x2_t __attribute__((ext_vector_type(2)));
    f32x2_t v = {lo, hi}; bf16x2_t b = __builtin_convertvector(v, bf16x2_t); return __builtin_bit_cast(unsigned, b); }
__device__ __forceinline__ s16x4 vtr(const ALAS char* p) { typedef short v4i16_t __attribute__((ext_vector_type(4))); return __builtin_bit_cast(s16x4, __builtin_amdgcn_ds_read_tr16_b64_v4i16((ALAS v4i16_t*)p)); }
__device__ __forceinline__ float swapmax(float m) { auto rr = __builtin_amdgcn_permlane32_swap(__float_as_uint(m), __float_as_uint(m), false, false); return __builtin_fmaxf(__uint_as_float(rr[0]), __uint_as_float(rr[1])); }
__device__ __forceinline__ float swapsum(float m) { auto rr = __builtin_amdgcn_permlane32_swap(__float_as_uint(m), __float_as_uint(m), false, false); return __uint_as_float(rr[0]) + __uint_as_float(rr[1]); }
__device__ __forceinline__ void glds_k4(const void* sbase, unsigned voff, unsigned lds_dst) { unsigned keep;
    asm volatile("s_mov_b32 %0, m0\n\ts_mov_b32 m0, %3\n\ts_nop 0\n\tglobal_load_lds_dwordx4 %1, %2\n\tglobal_load_lds_dwordx4 %1, %2 offset:1024\n\tglobal_load_lds_dwordx4 %1, %2 offset:2048\n\tglobal_load_lds_dwordx4 %1, %2 offset:3072\n\ts_mov_b32 m0, %0"
                 : "=&s"(keep) : "v"(voff), "s"(sbase), "s"(lds_dst) : "memory"); }
__device__ __forceinline__ void glds_v2(const void* sbase, unsigned voff, unsigned lds_dst) { unsigned keep;
    asm volatile("s_mov_b32 %0, m0\n\ts_mov_b32 m0, %3\n\ts_nop 0\n\tglobal_load_lds_dwordx4 %1, %2\n\tglobal_load_lds_dwordx4 %1, %2 offset:1024\n\ts_mov_b32 m0, %0" : "=&s"(keep) : "v"(voff), "s"(sbase), "s"(lds_dst) : "memory"); }
#define WAITBAR(last) do { if (last) asm volatile("s_waitcnt vmcnt(0) lgkmcnt(0)\n\ts_barrier" ::: "memory"); else if (kwave) asm volatile("s_waitcnt vmcnt(4) lgkmcnt(0)\n\ts_barrier" ::: "memory"); \
        else asm volatile("s_waitcnt vmcnt(2) lgkmcnt(0)\n\ts_barrier" ::: "memory"); } while (0)
#define MX3(a, b, c) __builtin_fmaxf(__builtin_fmaxf((a), (b)), (c))
#define SBAR() __builtin_amdgcn_sched_barrier(0)
#define PIN(x) asm volatile("" : "+v"(x))
#define EX(v) ((MODE & 2) ? (v) * 0.5f : __builtin_amdgcn_exp2f(v))

struct Tensors { const bf16_t *Q, *K, *V; bf16_t* MIX; const float* subg; float lam; const float* kmax; };
constexpr int PART_F32 = 64 + 4 * 8 * 64;
constexpr int META_CHUNKS = 7;
__device__ __forceinline__ void meta_chunk(int c, int& tb, int& te) { tb = c < 5 ? 19 * c : 95 + 17 * (c - 5); te = tb + (c < 5 ? 19 : 17); }


template <int THRL, int MODE = 0>
__device__ __forceinline__ void attn_unit(const Tensors& T, int b, int h, int qrow0, int nvalid, int tb, int te, float* part, ALAS char* shm, const int wid) {
    const int lane = hw_lane(), r32 = lane & 31, hi = lane >> 5;
    const int sub = wid & 1, rg = wid >> 1, rgq = part ? 0 : rg;
    ALAS float* wsf = (ALAS float*)(shm + OFF_WS) + wid * 64;
    const unsigned lds0 = (unsigned)(uintptr_t)shm;
    const bool kwave = wid < 4;
    const char* gsrc = kwave ? (const char*)T.K + ((size_t)((b * 8 + h * 2 + (wid >> 1)) * NTILE)) * 8192 + (wid & 1) * 4096
                             : (const char*)T.V + ((size_t)((b * 4 + h) * NTILE)) * 8192 + (wid - 4) * 2048;
    const int tstride = 8192;
    const unsigned ldst = lds0 + (kwave ? (unsigned)(OFF_K + wid * 4096) : (unsigned)(OFF_V + (wid - 4) * 2048));
    const unsigned lane16 = (unsigned)lane * 16u;
#define ATT_ISSUE(tt, so) do { const char* sb_ = gsrc + (size_t)(tt) * tstride; const unsigned d_ = ldst + (unsigned)(so); \
        if (kwave) glds_k4(sb_, lane16, d_); else glds_v2(sb_, lane16, d_); } while (0)
    if (kwave) { ATT_ISSUE(tb, 0); ATT_ISSUE(tb + 1, SLOT); } else { ATT_ISSUE(tb, 0); }
    bf16x8 qr[4];
    { const bf16_t* qp = T.Q + (size_t)(qrow0 + rgq * 32 + (part ? (r32 & 15) : r32)) * AW + h * 128 + sub * 64 + hi * 8;
#pragma unroll
      for (int d0 = 0; d0 < 4; ++d0) qr[d0] = *(const bf16x8*)(qp + d0 * 16); }
    asm volatile("" : "+v"(qr[0]), "+v"(qr[1]), "+v"(qr[2]), "+v"(qr[3]));
    f32x16 o[4];
#pragma unroll
    for (int d = 0; d < 4; ++d) o[d] = f32x16{};
    float mref = 0.f;
    f32x16 negm = f32x16{}; PIN(negm);
    int sclA = 0x7f7f7f7f, sclB = 0x7b7b7b7b; PIN(sclA); PIN(sclB);
    f32x4_t lacc = f32x4_t{};
    const int lq0 = ((lane & 15) >> 3) * 16 + 4 * (lane >> 4);
    { const unsigned pat_ = (((lane >> 4) & 1) == ((lane & 15) >> 3)) ? 0x38383838u : 0u; const u32x4 pv_ = (u32x4){pat_, pat_, pat_, pat_};
      *(ALAS u32x4*)(shm + OFF_ONES + lane * 16) = pv_; *(ALAS u32x4*)(shm + OFF_ONES + 1024 + lane * 16) = pv_; }
    const ALAS char* onesp = (const ALAS char*)shm + OFF_ONES + lane * 16;
    const ALAS char* kp0 = (const ALAS char*)shm + OFF_K + sub * 8192 + hi * 1024 + r32 * 16;
    const ALAS char* vp0 = (const ALAS char*)shm + OFF_V + hi * 1024 + r32 * 16;
    f32x16 pA0, pA1, pB0, pB1; i32x8 pa = i32x8{};
    bf16x8 kf[4]; i32x8 vfa, vfb;
    WAITBAR(false);
    if (kwave) { ATT_ISSUE(tb + 2, 2 * SLOT); } else { ATT_ISSUE(tb + 1, SLOT); }
    {
#pragma unroll
        for (int d0 = 0; d0 < 4; ++d0) { const bf16x8 k0 = *(const ALAS bf16x8*)(kp0 + d0 * 2048), k1 = *(const ALAS bf16x8*)(kp0 + d0 * 2048 + 512);
            if (d0 == 0) { pA0 = __builtin_amdgcn_mfma_f32_32x32x16_bf16(k0, qr[0], negm, 0, 0, 0); pA1 = __builtin_amdgcn_mfma_f32_32x32x16_bf16(k1, qr[0], negm, 0, 0, 0); }
            else { pA0 = __builtin_amdgcn_mfma_f32_32x32x16_bf16(k0, qr[d0], pA0, 0, 0, 0); pA1 = __builtin_amdgcn_mfma_f32_32x32x16_bf16(k1, qr[d0], pA1, 0, 0, 0); } }
        if (tb == 0) {
#pragma unroll
            for (int r = 8; r < 16; ++r) pA0[r] = -INFINITY;
#pragma unroll
            for (int r = 0; r < 16; ++r) pA1[r] = -INFINITY;
        }
        float rm = __builtin_fmaxf(pA0[0], pA1[0]);
#pragma unroll
        for (int r = 1; r < 16; ++r) rm = __builtin_fmaxf(rm, __builtin_fmaxf(pA0[r], pA1[r]));
        rm = swapmax(rm);
        mref = rm - 2.0f;
#pragma unroll
        for (int r = 0; r < 16; ++r) { pA0[r] = EX(pA0[r] - mref); pA1[r] = EX(pA1[r] - mref); }
#pragma unroll
        for (int r = 0; r < 16; ++r) negm[r] = -mref;
        PIN(negm);
    }
    WAITBAR(false);
    int ks_cur = SLOT, ks_nx2 = 0;
    int vs_prv = 0, vs_nx1 = 2 * SLOT;
#define PK4(P, B, OLD) __builtin_amdgcn_cvt_pk_fp8_f32(P[(B) + 2], P[(B) + 3], __builtin_amdgcn_cvt_pk_fp8_f32(P[B], P[(B) + 1], OLD, false), true)
#define KRD(j) (*(const ALAS bf16x8*)(kp_ + ((j) >> 1) * 2048 + ((j) & 1) * 512))
#define VLD(d) __builtin_shufflevector(*(const ALAS i32x4*)(vp_ + (d) * 2048), *(const ALAS i32x4*)(vp_ + (d) * 2048 + 512), 0, 1, 2, 3, 4, 5, 6, 7)
#define ONESLD() __builtin_shufflevector(*(const ALAS i32x4*)(onesp), *(const ALAS i32x4*)(onesp + 1024), 0, 1, 2, 3, 4, 5, 6, 7)
#define LSUM(B) asm volatile("v_mfma_scale_f32_16x16x128_f8f6f4 %0, %1, %2, %0, %3, %3 op_sel_hi:[0,0,0]" : "+v"(lacc) : "v"(pa), "v"(B), "v"(sclA))
#define PVMFMA(acc, B) asm volatile("v_mfma_scale_f32_32x32x64_f8f6f4 %0, %1, %2, %0, %3, %4 op_sel_hi:[0,0,0]" : "+v"(acc) : "v"(pa), "v"(B), "v"(sclA), "v"(sclB))
#define RECENTER(P0, P1) \
        float pm_ = MX3(P0[0], P0[1], P1[0]), pq_ = MX3(P0[2], P0[3], P1[1]); pm_ = MX3(pm_, P1[2], P1[3]); \
        _Pragma("unroll") for (int r = 4; r < 16; r += 4) { pm_ = MX3(pm_, P0[r], P0[r + 1]); pq_ = MX3(pq_, P0[r + 2], P0[r + 3]); pm_ = MX3(pm_, P1[r], P1[r + 1]); pq_ = MX3(pq_, P1[r + 2], P1[r + 3]); } \
        pm_ = swapmax(__builtin_fminf(__builtin_fmaxf(pm_, pq_), 3.0e38f)); \
        const float dl_ = __builtin_fmaxf(__builtin_amdgcn_logf(pm_) - 2.0f, 0.f), f_ = __builtin_amdgcn_exp2f(-dl_); \
        mref += dl_; \
        _Pragma("unroll") for (int r = 0; r < 16; ++r) { P0[r] = __builtin_fminf(P0[r], 3.0e38f) * f_; P1[r] = __builtin_fminf(P1[r], 3.0e38f) * f_; } \
        pa[0] = PK4(P0, 0, pa[0]); pa[1] = PK4(P0, 4, pa[1]); pa[2] = PK4(P0, 8, pa[2]); pa[3] = PK4(P0, 12, pa[3]); \
        pa[4] = PK4(P1, 0, pa[4]); pa[5] = PK4(P1, 4, pa[5]); pa[6] = PK4(P1, 8, pa[6]); pa[7] = PK4(P1, 12, pa[7]); PIN(pa); \
        _Pragma("unroll") for (int r = 0; r < 16; ++r) negm[r] = -mref; PIN(negm); \
        if (hi == 0) wsf[r32] = f_; \
        asm volatile("s_nop 15\n\ts_nop 15" ::: "memory"); _Pragma("unroll") for (int d = 0; d < 4; ++d) PIN(o[d]); PIN(lacc); \
        _Pragma("unroll") for (int r = 0; r < 4; ++r) lacc[r] *= wsf[lq0 + r]; PIN(lacc); \
        _Pragma("unroll") for (int r = 0; r < 16; ++r) { const float fr_ = wsf[crow(r, hi)]; _Pragma("unroll") for (int d = 0; d < 4; ++d) o[d][r] *= fr_; } \
        _Pragma("unroll") for (int d = 0; d < 4; ++d) PIN(o[d]); asm volatile("s_nop 7" ::: "memory");
#define FILLA(P0, P1, j) do { \
        if ((j) == 0) { pa[0] = PK4(P0, 0, pa[0]); } if ((j) == 1) { pa[1] = PK4(P0, 4, pa[1]); } if ((j) == 2) { pa[2] = PK4(P0, 8, pa[2]); } if ((j) == 3) { pa[3] = PK4(P0, 12, pa[3]); } \
        if ((j) == 4) { pa[4] = PK4(P1, 0, pa[4]); } if ((j) == 5) { pa[5] = PK4(P1, 4, pa[5]); } if ((j) == 6) { pa[6] = PK4(P1, 8, pa[6]); } if ((j) == 7) { pa[7] = PK4(P1, 12, pa[7]); } \
        } while (0)
#define OVF8() ((((((unsigned)pa[0] + 0x02020202u) | ((unsigned)pa[1] + 0x02020202u) | ((unsigned)pa[2] + 0x02020202u)) | (((unsigned)pa[3] + 0x02020202u) | ((unsigned)pa[4] + 0x02020202u) | ((unsigned)pa[5] + 0x02020202u))) \
                | (((unsigned)pa[6] + 0x02020202u) | ((unsigned)pa[7] + 0x02020202u))) & 0x80808080u)
#define GAPA(C0, C1, P0, P1, j) do { \
        if ((j) == 0) C0 = __builtin_amdgcn_mfma_f32_32x32x16_bf16(kf[0], qr[0], negm, 0, 0, 0); \
        else if ((j) == 1) C1 = __builtin_amdgcn_mfma_f32_32x32x16_bf16(kf[1], qr[0], negm, 0, 0, 0); \
        else if (((j) & 1) == 0) C0 = __builtin_amdgcn_mfma_f32_32x32x16_bf16(kf[(j) & 3], qr[(j) >> 1], C0, 0, 0, 0); \
        else C1 = __builtin_amdgcn_mfma_f32_32x32x16_bf16(kf[(j) & 3], qr[(j) >> 1], C1, 0, 0, 0); \
        if ((j) + 4 < 8) kf[(j) & 3] = KRD((j) + 4); \
        FILLA(P0, P1, j); SBAR(); } while (0)
#define GAPB(C0, C1, i) do { \
        if ((i) == 0) PVMFMA(o[0], vfa); if ((i) == 4) PVMFMA(o[1], vfb); if ((i) == 8) PVMFMA(o[2], vfa); if ((i) == 12) PVMFMA(o[3], vfb); \
        if ((i) == 1) vfa = VLD(2); if ((i) == 5) vfb = VLD(3); if ((i) == 9) vfa = ONESLD(); if ((i) == 15) LSUM(vfa); \
        if ((i) < 8) { C0[2 * (i)] = EX(C0[2 * (i)]); C0[2 * (i) + 1] = EX(C0[2 * (i) + 1]); } \
        else { C1[2 * (i) - 16] = EX(C1[2 * (i) - 16]); C1[2 * (i) - 15] = EX(C1[2 * (i) - 15]); } \
        SBAR(); } while (0)
#define STEP(C0, C1, P0, P1, t) do { SBAR(); asm volatile("" : "+s"(wsel)); const bool kw_ = wsel < 4; \
        const ALAS char* kp_ = kp0 + ks_cur; const ALAS char* vp_ = vp0 + vs_prv; \
        kf[0] = KRD(0); kf[1] = KRD(1); kf[2] = KRD(2); kf[3] = KRD(3); SBAR(); \
        if (kw_) { if ((t) + 2 < te) glds_k4(gnext, lane16, ldst + (unsigned)ks_nx2); } else { if ((t) + 1 < te) glds_v2(gnext, lane16, ldst + (unsigned)vs_nx1); } gnext += 8192; \
        SBAR(); \
        GAPA(C0, C1, P0, P1, 0); GAPA(C0, C1, P0, P1, 1); GAPA(C0, C1, P0, P1, 2); GAPA(C0, C1, P0, P1, 3); \
        GAPA(C0, C1, P0, P1, 4); GAPA(C0, C1, P0, P1, 5); vfa = VLD(0); vfb = VLD(1); SBAR(); GAPA(C0, C1, P0, P1, 6); GAPA(C0, C1, P0, P1, 7); \
        if (__builtin_expect(__any(OVF8() != 0u), 0)) { RECENTER(P0, P1); \
            _Pragma("unroll") for (int r = 0; r < 16; ++r) { C0[r] -= dl_; C1[r] -= dl_; } } \
        SBAR(); if (!kw_) { if ((t) + 1 >= te) asm volatile("s_waitcnt vmcnt(0) lgkmcnt(0)\n\ts_barrier" ::: "memory"); else asm volatile("s_waitcnt vmcnt(2) lgkmcnt(0)\n\ts_barrier" ::: "memory"); } SBAR(); \
        GAPB(C0, C1, 0); GAPB(C0, C1, 1); GAPB(C0, C1, 2); GAPB(C0, C1, 3); GAPB(C0, C1, 4); GAPB(C0, C1, 5); GAPB(C0, C1, 6); GAPB(C0, C1, 7); \
        GAPB(C0, C1, 8); GAPB(C0, C1, 9); GAPB(C0, C1, 10); GAPB(C0, C1, 11); GAPB(C0, C1, 12); GAPB(C0, C1, 13); GAPB(C0, C1, 14); GAPB(C0, C1, 15); \
        PIN(C0); PIN(C1); SBAR(); \
        if (kw_) { if ((t) + 2 >= te) asm volatile("s_waitcnt vmcnt(0) lgkmcnt(0)\n\ts_barrier" ::: "memory"); else asm volatile("s_waitcnt vmcnt(4) lgkmcnt(0)\n\ts_barrier" ::: "memory"); } \
        { const int nk_ = ks_cur + SLOT; const int kn_ = nk_ == 3 * SLOT ? 0 : nk_; ks_nx2 = ks_cur; ks_cur = kn_; } \
        { const int nv_ = vs_prv + SLOT; const int vn_ = nv_ == 3 * SLOT ? 0 : nv_; vs_nx1 = vs_prv; vs_prv = vn_; } \
    } while (0)
    const char* gnext = gsrc + (size_t)(tb + (kwave ? 3 : 2)) * 8192;
    int wsel = wid;
#pragma unroll 1
    for (int t = tb + 1; t < te; t += 2) {
        STEP(pB0, pB1, pA0, pA1, t);
        STEP(pA0, pA1, pB0, pB1, t + 1);
    }
    { pa[0] = PK4(pA0, 0, pa[0]); pa[1] = PK4(pA0, 4, pa[1]); pa[2] = PK4(pA0, 8, pa[2]); pa[3] = PK4(pA0, 12, pa[3]); pa[4] = PK4(pA1, 0, pa[4]); pa[5] = PK4(pA1, 4, pa[5]); pa[6] = PK4(pA1, 8, pa[6]); pa[7] = PK4(pA1, 12, pa[7]); PIN(pa);
      if (__any(OVF8() != 0u)) { RECENTER(pA0, pA1); (void)dl_; }
      const ALAS char* vp_ = vp0 + vs_prv;
      vfa = VLD(0); vfb = VLD(1); PVMFMA(o[0], vfa); PVMFMA(o[1], vfb); PIN(vfa); PIN(vfb); vfa = VLD(2); vfb = VLD(3); PVMFMA(o[2], vfa); PVMFMA(o[3], vfb); PIN(vfa); vfa = ONESLD(); LSUM(vfa);
      asm volatile("s_nop 15\n\ts_nop 15" ::: "memory");
#pragma unroll
      for (int d = 0; d < 4; ++d) PIN(o[d]);
      PIN(lacc); }
#undef ATT_ISSUE
#undef PK4
#undef KRD
#undef VLD
#undef PVMFMA
#undef FILLA
#undef OVF8
#undef LSUM
#undef ONESLD
#undef RECENTER
#undef GAPA
#undef GAPB
#undef STEP
    if (part) {
        if (rg == 0) { float* pp = part + (size_t)sub * PART_F32;
            if (hi == 0) pp[r32] = mref;
            if ((lane & 7) == 0) {
#pragma unroll
                for (int r = 0; r < 4; ++r) pp[32 + lq0 + r] = lacc[r]; }
#pragma unroll
            for (int d = 0; d < 4; ++d)
#pragma unroll
                for (int r = 0; r < 8; ++r) pp[64 + (d * 8 + r) * 64 + lane] = o[d][r]; }
        asm volatile("s_waitcnt lgkmcnt(0)\n\ts_barrier" ::: "memory");
        return;
    }
    if ((lane & 7) == 0) {
#pragma unroll
        for (int r = 0; r < 4; ++r) wsf[32 + lq0 + r] = lacc[r]; }
    float rli[16];
#pragma unroll
    for (int r = 0; r < 16; ++r) rli[r] = 1.0f / wsf[32 + crow(r, hi)];
    asm volatile("s_waitcnt lgkmcnt(0)\n\ts_barrier" ::: "memory");
    ALAS float* X = (ALAS float*)shm + (size_t)rg * 4096 + lane;
    if (sub == 1) {
#pragma unroll
        for (int d = 0; d < 4; ++d)
#pragma unroll
            for (int r = 0; r < 16; ++r) X[(d * 16 + r) * 64] = o[d][r] * rli[r] * T.lam;
    }
    asm volatile("s_waitcnt lgkmcnt(0)\n\ts_barrier" ::: "memory");
    if (sub == 0) {
        float ss[16];
#pragma unroll
        for (int r = 0; r < 16; ++r) { float s = 0.f;
#pragma unroll
            for (int d = 0; d < 4; ++d) { const float v = o[d][r] * rli[r] - X[(d * 16 + r) * 64]; o[d][r] = v; s += v * v; }
            ss[r] = s; }
#pragma unroll
        for (int r = 0; r < 16; ++r) {
#pragma unroll
            for (int m = 1; m < 32; m <<= 1) ss[r] += __shfl_xor(ss[r], m);
            ss[r] = rsqrtf(ss[r] * (1.0f / 128.0f) + NORM_EPS) * (1.0f - LAM_INIT); }
        float gg[4];
#pragma unroll
        for (int d = 0; d < 4; ++d) gg[d] = T.subg[d * 32 + r32];
#pragma unroll
        for (int r = 0; r < 16; ++r) { const int rowi = rg * 32 + crow(r, hi);
            if (rowi < nvalid) { bf16_t* op = T.MIX + (size_t)(qrow0 + rowi) * D + h * 128 + r32;
#pragma unroll
                for (int d = 0; d < 4; ++d) { const float y = o[d][r] * ss[r] * gg[d]; op[d * 32] = (bf16_t)(cvtpk(y, y) & 0xffffu); } } }
    }
    asm volatile("s_waitcnt lgkmcnt(0)\n\ts_barrier" ::: "memory");
}

__device__ __forceinline__ void meta_combine(const Tensors& T, const float* parts, int bh, int lane) {
    const int r32 = lane & 31, hi = lane >> 5, b = bh >> 2, h = bh & 3;
    float osub[2][4][8];
#pragma unroll
    for (int sub = 0; sub < 2; ++sub) {
        float M[8], L[8];
#pragma unroll
        for (int r = 0; r < 8; ++r) { M[r] = -INFINITY; L[r] = 0.f; }
#pragma unroll
        for (int d = 0; d < 4; ++d)
#pragma unroll
            for (int r = 0; r < 8; ++r) osub[sub][d][r] = 0.f;
#pragma unroll 1
        for (int c = 0; c < META_CHUNKS; ++c) { asm volatile("" ::: "memory"); const float* pp = parts + ((size_t)(bh * META_CHUNKS + c) * 2 + sub) * PART_F32;
#pragma unroll
            for (int r = 0; r < 8; ++r) { const int row = crow(r, hi); const float mc = pp[row], lc = pp[32 + row];
                const float mn = __builtin_fmaxf(M[r], mc), fo = __builtin_amdgcn_exp2f(M[r] - mn), fc = __builtin_amdgcn_exp2f(mc - mn);
                M[r] = mn; L[r] = L[r] * fo + lc * fc;
#pragma unroll
                for (int d = 0; d < 4; ++d) osub[sub][d][r] = osub[sub][d][r] * fo + pp[64 + (d * 8 + r) * 64 + lane] * fc; } }
#pragma unroll
        for (int r = 0; r < 8; ++r) { const float rl = 1.0f / L[r];
#pragma unroll
            for (int d = 0; d < 4; ++d) osub[sub][d][r] *= rl; }
    }
    float gg[4];
#pragma unroll
    for (int d = 0; d < 4; ++d) gg[d] = T.subg[d * 32 + r32];
#pragma unroll
    for (int r = 0; r < 8; ++r) { float v[4], s = 0.f;
#pragma unroll
        for (int d = 0; d < 4; ++d) { v[d] = osub[0][d][r] - T.lam * osub[1][d][r]; s += v[d] * v[d]; }
#pragma unroll
        for (int m = 1; m < 32; m <<= 1) s += __shfl_xor(s, m);
        const float sc = rsqrtf(s * (1.0f / 128.0f) + NORM_EPS) * (1.0f - LAM_INIT);
        bf16_t* op = T.MIX + (size_t)(RMETA + NMETA * b + crow(r, hi)) * D + h * 128 + r32;
#pragma unroll
        for (int d = 0; d < 4; ++d) { const float y = v[d] * sc * gg[d]; op[d * 32] = (bf16_t)(cvtpk(y, y) & 0xffffu); } }
}
#undef MX3
#undef WAITBAR
#undef SBAR
#undef PIN
#undef EX
}
#define XB_TMO      128
#define XB_XCNT(j)  (256  + 64 * (j))
#define XB_XSUB(j)  (1280 + 64 * (j))
#define XB_XGEN(j)  (2304 + 64 * (j))
#define XB_TOP      3328
#define XB_TOPGEN   3392
#define XCD_BAR_WORDS 3456
#define XB_SPIN_CAP (1u << 18)

__device__ __forceinline__ unsigned xb_ld(unsigned* p)              { return __hip_atomic_load(p, __ATOMIC_RELAXED, __HIP_MEMORY_SCOPE_AGENT); }
__device__ __forceinline__ unsigned xb_add(unsigned* p, unsigned v) { return __hip_atomic_fetch_add(p, v, __ATOMIC_RELAXED, __HIP_MEMORY_SCOPE_AGENT); }
__device__ __forceinline__ unsigned xb_xcc_id() { return (unsigned)__builtin_amdgcn_s_getreg((3 << 11) | 20) & 0xFu; }
#define XB_SPIN(cond, bar) do { unsigned _sp = 0; while (cond) { __builtin_amdgcn_s_sleep(1); \
    if ((++_sp & 255u) == 0u) { if (xb_ld(&(bar)[XB_TMO])) break; if (_sp > XB_SPIN_CAP) { atomicAdd(&(bar)[XB_TMO], 1u); break; } } } } while (0)

struct XcdBarrier {
    unsigned* bar; unsigned x;
    volatile LAS unsigned* st;
};

__device__ __forceinline__ XcdBarrier xcd_barrier_post(unsigned* bar, volatile LAS unsigned* st) {
    XcdBarrier b; b.bar = bar; b.x = xb_xcc_id(); b.st = st;
    if (threadIdx.x == 0) (void)xb_add(&bar[XB_XCNT(b.x)], 1u);
    return b;
}
__device__ __forceinline__ void xcd_barrier_complete(unsigned* bar, unsigned x, unsigned& nloc, unsigned& nx) {
    const unsigned G = gridDim.x * gridDim.y * gridDim.z;
    unsigned sum, cnt, mine, sp = 0u;
    for (;;) {
        sum = 0u; cnt = 0u; mine = 0u;
#pragma unroll
        for (unsigned j = 0; j < 16; ++j) { const unsigned c = xb_ld(&bar[XB_XCNT(j)]); sum += c; cnt += (c > 0u) ? 1u : 0u; mine = (j == x) ? c : mine; }
        if (sum == G) break;
        __builtin_amdgcn_s_sleep(1);
        if ((++sp & 255u) == 0u) { if (xb_ld(&bar[XB_TMO])) break; if (sp > XB_SPIN_CAP) { atomicAdd(&bar[XB_TMO], 1u); break; } }
    }
    nloc = mine > 0u ? mine : 1u; nx = cnt > 0u ? cnt : 1u;
}

__device__ __forceinline__ void xcd_barrier(const XcdBarrier& b) {
    asm volatile("s_waitcnt vmcnt(0)" ::: "memory");
    __syncthreads();
    if (threadIdx.x == 0) {
        unsigned* bar = b.bar;
        __builtin_amdgcn_s_waitcnt(0);
        unsigned nloc = b.st[0], nx = b.st[1];
        if (nloc == 0u) { xcd_barrier_complete(bar, b.x, nloc, nx); b.st[0] = nloc; b.st[1] = nx; }
        const unsigned old = xb_add(&bar[XB_XSUB(b.x)], 1u);
        const unsigned gen = old / nloc;
        if (old + 1u == (gen + 1u) * nloc) {
            __builtin_amdgcn_fence(__ATOMIC_RELEASE, "agent");
            asm volatile("s_waitcnt vmcnt(0)" ::: "memory");
            const unsigned og = xb_add(&bar[XB_TOP], 1u);
            const unsigned tg = og / nx;
            if (og + 1u == (tg + 1u) * nx) xb_add(&bar[XB_TOPGEN], 1u);
            else XB_SPIN(xb_ld(&bar[XB_TOPGEN]) == tg, bar);
            __builtin_amdgcn_fence(__ATOMIC_ACQUIRE, "agent");
            xb_add(&bar[XB_XGEN(b.x)], 1u);
            asm volatile("s_waitcnt vmcnt(0)" ::: "memory");
        } else {
            XB_SPIN(xb_ld(&bar[XB_XGEN(b.x)]) == gen, bar);
            __builtin_amdgcn_fence(__ATOMIC_ACQUIRE, "agent");
            asm volatile("s_waitcnt vmcnt(0)" ::: "memory");
        }
    }
    __syncthreads();
}
struct Ctx {
    LAS unsigned char* lds; int wave, G, gw, NGW;
    const float* in[17]; float* out; unsigned char* ws;
};
__device__ __forceinline__ int colmap_in(int np) {
    const int pn = np >> 8, c = np & 255, bj = c >> 7, cc = c & 127;
    if (pn < 4) return (pn >> 1) * AW + ((pn & 1) * 4 + (cc >> 5)) * 64 + bj * 32 + (cc & 31);
    if (pn < 6) return 2 * AW + (pn - 4) * 256 + c;
    if (pn < 10) return (bj ? 3 * AW + 2 * CWID : 3 * AW) + (pn - 6) * 128 + cc;
    return 3 * AW + CWID + (pn - 10) * 256 + c;
}
__device__ __forceinline__ void tr_item(const float* W, int N, int k0, int c0, bf16* WT, int r0, int K, LAS float* scr, int lane) {
    float t_[32];
#pragma unroll
    for (int i = 0; i < 32; ++i) t_[i] = W[(size_t)(k0 + 2 * i + (lane >> 5)) * N + c0 + (lane & 31)];
#pragma unroll
    for (int i = 0; i < 32; ++i) scr[(2 * i + (lane >> 5)) * 33 + (lane & 31)] = t_[i];
    LDS_WAIT(); asm volatile("" ::: "memory");
    const int c = lane & 7;
#pragma unroll
    for (int j = 0; j < 4; ++j) { const int n = (lane >> 3) + 8 * j; const LAS float* s = scr + (8 * c) * 33 + n;
        v4u o; o.x = pk2(s[0 * 33], s[1 * 33]); o.y = pk2(s[2 * 33], s[3 * 33]); o.z = pk2(s[4 * 33], s[5 * 33]); o.w = pk2(s[6 * 33], s[7 * 33]);
        *(GAS v4u*)(WT + (size_t)(r0 + n) * K + k0 + 8 * c) = o; }
    LDS_WAIT(); asm volatile("" ::: "memory");
}
__device__ __forceinline__ void tr_item8(const float* W, int N, int k0, int c0, unsigned char* WT, int r0, int K, LAS float* scr, int lane) {
    float t_[32];
#pragma unroll
    for (int i = 0; i < 32; ++i) t_[i] = W[(size_t)(k0 + 2 * i + (lane >> 5)) * N + c0 + (lane & 31)];
#pragma unroll
    for (int i = 0; i < 32; ++i) scr[(2 * i + (lane >> 5)) * 33 + (lane & 31)] = t_[i];
    LDS_WAIT(); asm volatile("" ::: "memory");
    const int c = lane & 3;
#pragma unroll
    for (int j = 0; j < 2; ++j) { const int n = (lane >> 2) + 16 * j; const LAS float* s = scr + (16 * c) * 33 + n; v4u o;
#pragma unroll
        for (int q = 0; q < 4; ++q) { int w = __builtin_amdgcn_cvt_pk_fp8_f32(64.f * s[(4 * q) * 33], 64.f * s[(4 * q + 1) * 33], 0, false);
            w = __builtin_amdgcn_cvt_pk_fp8_f32(64.f * s[(4 * q + 2) * 33], 64.f * s[(4 * q + 3) * 33], w, true); o[q] = (unsigned)w; }
        *(GAS v4u*)(WT + (size_t)(r0 + n) * K + k0 + 16 * c) = o; }
    LDS_WAIT(); asm volatile("" ::: "memory");
}
__device__ __forceinline__ void expert_item(Ctx& F, int it, LAS float* scr, int lane) {
    constexpr int I_GU = 16 * 128, I_DN = 32 * 32, I_E = I_GU + I_DN;
    unsigned char* W1 = F.ws + WS_W1; unsigned char* W2 = F.ws + WS_W2;
    const int e = it / I_E; int r = it - e * I_E;
    if (r < I_GU) { const int kb = r / 128, nb = r % 128, np = 32 * nb, c = np & 255; const float* src = ((c >> 7) ? F.in[14] : F.in[13]) + (size_t)e * D * FF;
        tr_item8(src, FF, 64 * kb, (np >> 8) * 128 + (c & 127), W1 + (size_t)e * 2 * FF * D, np, D, scr, lane); return; } r -= I_GU;
    { const int kb = r / 32, nb = r % 32; tr_item8(F.in[15] + (size_t)e * FF * D, D, 64 * kb, 32 * nb, W2 + (size_t)e * D * FF, 32 * nb, FF, scr, lane); }
}
__device__ __forceinline__ void p0_prologue(Ctx& F) {
    const int lane_ = hw_lane(), tid_ = F.wave * 64 + lane_; (void)tid_;
    LAS float* scr = (LAS float*)(F.lds + RING_OFF + F.wave * 16384);
    bf16* WIN = (bf16*)(F.ws + WS_WIN); bf16* WOUT = (bf16*)(F.ws + WS_WOUT);
    constexpr int I_IN = 16 * 96, I_OUT = 16 * 32, NITEMS = I_IN + I_OUT;
    for (int it = F.gw; it < NITEMS; it += F.NGW) {
        int r = it;
        if (r < I_IN) { const int kb = r / 96, nb = r % 96; tr_item(F.in[3], NPROJ, 64 * kb, colmap_in(32 * nb), WIN, 32 * nb, D, scr, lane_); continue; } r -= I_IN;
        { const int kb = r / 32, nb = r % 32; tr_item(F.in[10], D, 64 * kb, 32 * nb, WOUT, 32 * nb, D, scr, lane_); }
    }
    bf16* XN = (bf16*)(F.ws + WS_XN); const float* gsrc = F.in[2];
    f32x4 gv[4];
#pragma unroll
    for (int j = 0; j < 2; ++j) { gv[2 * j] = *(const GAS f32x4*)(gsrc + 8 * lane_ + 512 * j); gv[2 * j + 1] = *(const GAS f32x4*)(gsrc + 8 * lane_ + 512 * j + 4); }
    for (int r = F.gw; r < RP; r += F.NGW) {
        GAS v4u* o = (GAS v4u*)(XN + (size_t)r * D + 8 * lane_);
        if (r >= RV) { o[0] = (v4u){0u, 0u, 0u, 0u}; o[64] = (v4u){0u, 0u, 0u, 0u}; continue; }
        const float* src = r < RX ? F.in[0] + (size_t)r * D : F.in[1] + (size_t)((r - RX) & (NMETA - 1)) * D;
        f32x4 v[4]; float s = 0.f;
#pragma unroll
        for (int j = 0; j < 2; ++j) { v[2 * j] = *(const GAS f32x4*)(src + 8 * lane_ + 512 * j); v[2 * j + 1] = *(const GAS f32x4*)(src + 8 * lane_ + 512 * j + 4); }
#pragma unroll
        for (int j = 0; j < 4; ++j) s += (v[j].x * v[j].x + v[j].y * v[j].y) + (v[j].z * v[j].z + v[j].w * v[j].w);
        const float rstd = rsqrtf(wave_sum(s) * (1.f / D) + NORM_EPS);
#pragma unroll
        for (int j = 0; j < 2; ++j) { const f32x4 a = v[2 * j] * rstd * gv[2 * j], b = v[2 * j + 1] * rstd * gv[2 * j + 1];
            o[64 * j] = (v4u){pk2(a.x, a.y), pk2(a.z, a.w), pk2(b.x, b.y), pk2(b.z, b.w)}; }
    }
    { char* VI = (char*)(F.ws + WS_V);
      for (int i = F.gw; i < BATCH * 4 * 8; i += F.NGW) { const int bh = i >> 3, q = i & 7;
          *(GAS v4u*)(VI + (size_t)bh * KV_TILES * 8192 + q * 1024 + lane_ * 16) = (v4u){0u, 0u, 0u, 0u}; } }
    { bf16* RT = (bf16*)(F.ws + WS_RTAB); float* RG = (float*)(F.ws + WS_RTAB + (size_t)2 * 16 * 1032 * 2); const float* wr = F.in[12]; const float* gs = F.in[11];
      for (int i = F.gw * 64 + lane_; i < D * NEXP; i += F.NGW * 64) { const int k = i >> 4, e = i & 15; const float w = wr[i] * gs[k];
          const unsigned hb = pk2(w, w) & 0xffffu; const float hf = __uint_as_float(hb << 16); const unsigned lb = pk2(w - hf, w - hf) & 0xffffu;
          RT[e * 1032 + k] = (bf16)hb; RT[16 * 1032 + e * 1032 + k] = (bf16)lb; }
      for (int i = F.gw * 64 + lane_; i < D; i += F.NGW * 64) RG[i] = gs[i]; }
    float* rc = (float*)(F.ws + WS_ROPE); float* rs = rc + LSEQ * 32;
    for (int idx = (F.gw * 64 + lane_); idx < LSEQ * 32; idx += F.NGW * 64) {
        const int pos = idx >> 5, i = idx & 31;
        const float inv_freq = exp2f(-(float)i * (13.287712379549449f / 32.0f));
        const double ang = (double)pos * (double)inv_freq;
        const double n = __builtin_rint(ang * 0.15915494309189535);
        double rr = __builtin_fma(-n, 6.283185307179586, ang); rr = __builtin_fma(-n, 2.4492935982947064e-16, rr);
        const double z = rr * rr; double cs = 0.0, sn = 0.0;
        { double tc = 1.0, ts = 1.0;
#pragma unroll
          for (int k = 0; k < 14; ++k) { cs += tc; sn += ts; tc = -tc * z * (1.0 / (double)((2 * k + 1) * (2 * k + 2))); ts = -ts * z * (1.0 / (double)((2 * k + 2) * (2 * k + 3))); } }
        rc[idx] = (float)cs; rs[idx] = (float)(sn * rr);
    }
}
__device__ __forceinline__ void conv_rows(Ctx& F) {
    const int lane_ = hw_lane(), tid_ = F.wave * 64 + lane_; (void)tid_;
    const bf16* U = (const bf16*)(F.ws + WS_U); const bf16* CBb = (const bf16*)(F.ws + WS_CB); bf16* MIX = (bf16*)(F.ws + WS_XN);
    const float* cw = F.in[4]; float w[3][8];
#pragma unroll
    for (int j = 0; j < 3; ++j)
#pragma unroll
        for (int i = 0; i < 8; ++i) w[j][i] = cw[j * CWID + 8 * lane_ + i];
    for (int g = F.gw; g < RV / 4; g += F.NGW) {
        const int r0 = 4 * g; int prev, next;
        if (r0 < RX) { const int b = r0 >> 13, s = r0 & (SEQ - 1); prev = s > 0 ? r0 - 1 : RMETA + NMETA * b + NMETA - 1; next = s + 3 < SEQ - 1 ? r0 + 4 : -1; }
        else { const int m = r0 - RX, b = m >> 4, j = m & (NMETA - 1); prev = j > 0 ? r0 - 1 : -1; next = j + 3 < NMETA - 1 ? r0 + 4 : b * SEQ; }
        const v4u z = (v4u){0u, 0u, 0u, 0u};
        v4u uu[6], cb[4];
        uu[0] = prev >= 0 ? *(const GAS v4u*)(U + (size_t)prev * CWID + 8 * lane_) : z;
#pragma unroll
        for (int q = 0; q < 4; ++q) { uu[1 + q] = *(const GAS v4u*)(U + (size_t)(r0 + q) * CWID + 8 * lane_); cb[q] = *(const GAS v4u*)(CBb + (size_t)(r0 + q) * CWID + 8 * lane_); }
        uu[5] = next >= 0 ? *(const GAS v4u*)(U + (size_t)next * CWID + 8 * lane_) : z;
#pragma unroll
        for (int q = 0; q < 4; ++q) { float o[8];
#pragma unroll
            for (int t = 0; t < 4; ++t) {
                o[2 * t] = bf_lo(cb[q][t]) * (w[0][2 * t] * bf_lo(uu[q][t]) + w[1][2 * t] * bf_lo(uu[q + 1][t]) + w[2][2 * t] * bf_lo(uu[q + 2][t]));
                o[2 * t + 1] = bf_hi(cb[q][t]) * (w[0][2 * t + 1] * bf_hi(uu[q][t]) + w[1][2 * t + 1] * bf_hi(uu[q + 1][t]) + w[2][2 * t + 1] * bf_hi(uu[q + 2][t])); }
            *(GAS v4u*)(MIX + (size_t)(r0 + q) * D + AW + 8 * lane_) = (v4u){pk2(o[0], o[1]), pk2(o[2], o[3]), pk2(o[4], o[5]), pk2(o[6], o[7])}; }
    }
}
__device__ __forceinline__ void p4_norm_router(Ctx& F) {
    const int lane_ = hw_lane(), tid_ = F.wave * 64 + lane_;
    typedef short bf16x8_t __attribute__((ext_vector_type(8)));
    constexpr int WP = D + 8;
    LAS bf16* Wh = (LAS bf16*)(F.lds + RING_OFF); LAS bf16* Wl = Wh + NEXP * WP; LAS float* G = (LAS float*)(F.lds + RING_OFF + 2 * NEXP * WP * 2);
    { const v4u* src = (const v4u*)(F.ws + WS_RTAB); LAS v4u* dst = (LAS v4u*)(F.lds + RING_OFF);
      for (int i = tid_; i < (int)((2 * NEXP * WP * 2 + D * 4) / 16); i += 512) dst[i] = src[i]; }
    __syncthreads();
    unsigned char* HN2 = F.ws + WS_HN2; const bf16* H1B = (const bf16*)(F.ws + WS_H1B); float* AFF = (float*)(F.ws + WS_AFF); const float* H1M = (const float*)(F.ws + WS_H1M);
    const int rl = lane_ & 15, kq = lane_ >> 4;
    constexpr int N_EITEMS = NEXP * (16 * 128 + 32 * 32);
    LAS float* escr = (LAS float*)(F.lds + RING_OFF + 70656 + F.wave * 8448);
    int eit = F.gw;
    for (int t = F.gw; t < RV / 16 + F.NGW; t += F.NGW) {
        asm volatile("" ::: "memory");
        if (t >= RV / 16) { for (; eit < N_EITEMS; eit += F.NGW) expert_item(F, eit, escr, lane_); break; }
        const int row = 16 * t + rl;
        const bool xrow = t < RX / 16;
        const bf16* srcb = H1B + (size_t)row * D + 8 * kq; const float* srcf = H1M + (size_t)(xrow ? 0 : row - RX) * D + 8 * kq;
#define P4_LOAD8(s0) do { if (xrow) { _Pragma("unroll") for (int s = 0; s < 8; ++s) xr[s] = *(const GAS v4u*)(srcb + 32 * ((s0) + s)); } \
        else { _Pragma("unroll") for (int s = 0; s < 8; ++s) { const f32x4 a = *(const GAS f32x4*)(srcf + 32 * ((s0) + s)), b2 = *(const GAS f32x4*)(srcf + 32 * ((s0) + s) + 4); \
            xr[s] = (v4u){pk2(a.x, a.y), pk2(a.z, a.w), pk2(b2.x, b2.y), pk2(b2.z, b2.w)}; } } } while (0)
        v4u xr[8];
        f32x4 acc = (f32x4){0.f, 0.f, 0.f, 0.f}; float ss = 0.f;
#pragma unroll 1
        for (int s0 = 0; s0 < 32; s0 += 8) {
            asm volatile("" ::: "memory");
            P4_LOAD8(s0);
#pragma unroll
            for (int s = 0; s < 8; ++s) {
                const bf16x8_t bh = *(const LAS bf16x8_t*)(Wh + rl * WP + 32 * (s0 + s) + 8 * kq), bl = *(const LAS bf16x8_t*)(Wl + rl * WP + 32 * (s0 + s) + 8 * kq);
                const bf16x8_t af = __builtin_bit_cast(bf16x8_t, xr[s]);
                acc = __builtin_amdgcn_mfma_f32_16x16x32_bf16(af, bh, acc, 0, 0, 0);
                acc = __builtin_amdgcn_mfma_f32_16x16x32_bf16(af, bl, acc, 0, 0, 0);
#pragma unroll
                for (int q = 0; q < 4; ++q) { const float lo = bf_lo(xr[s][q]), hi = bf_hi(xr[s][q]); ss += lo * lo + hi * hi; } } }
        ss += __shfl_xor(ss, 16); ss += __shfl_xor(ss, 32);
        const float rstd = rsqrtf(ss * (1.f / D) + NORM_EPS);
        unsigned char* dst = HN2 + (size_t)row * D + 8 * kq;
#pragma unroll 1
        for (int s0 = 0; s0 < 32; s0 += 8) {
            asm volatile("" ::: "memory");
            P4_LOAD8(s0);
#pragma unroll
            for (int s = 0; s < 8; ++s) { const f32x4 g0 = *(const LAS f32x4*)(G + 32 * (s0 + s) + 8 * kq), g1 = *(const LAS f32x4*)(G + 32 * (s0 + s) + 8 * kq + 4);
                int w0 = __builtin_amdgcn_cvt_pk_fp8_f32(bf_lo(xr[s][0]) * rstd * g0.x, bf_hi(xr[s][0]) * rstd * g0.y, 0, false); w0 = __builtin_amdgcn_cvt_pk_fp8_f32(bf_lo(xr[s][1]) * rstd * g0.z, bf_hi(xr[s][1]) * rstd * g0.w, w0, true);
                int w1 = __builtin_amdgcn_cvt_pk_fp8_f32(bf_lo(xr[s][2]) * rstd * g1.x, bf_hi(xr[s][2]) * rstd * g1.y, 0, false); w1 = __builtin_amdgcn_cvt_pk_fp8_f32(bf_lo(xr[s][3]) * rstd * g1.z, bf_hi(xr[s][3]) * rstd * g1.w, w1, true);
                *(GAS v2u*)(dst + 32 * (s0 + s)) = (v2u){(unsigned)w0, (unsigned)w1}; } }
#undef P4_LOAD8
#pragma unroll
        for (int reg = 0; reg < 4; ++reg) { const int rr = 4 * kq + reg; const float lg = acc[reg] * __shfl(rstd, rr);
            float mx = lg;
#pragma unroll
            for (int m = 1; m < 16; m <<= 1) mx = fmaxf(mx, __shfl_xor(mx, m));
            const float ex = expf(lg - mx); float sm = ex;
#pragma unroll
            for (int m = 1; m < 16; m <<= 1) sm += __shfl_xor(sm, m);
            const int r = 16 * t + rr; const int b = r < RX ? r >> 13 : (r - RX) >> 4, pos = r < RX ? NMETA + (r & (SEQ - 1)) : ((r - RX) & (NMETA - 1));
            AFF[((size_t)b * NEXP + rl) * LSEQ + pos] = ex / sm; }
        for (int j = 0; j < 12 && eit < N_EITEMS; ++j, eit += F.NGW) expert_item(F, eit, escr, lane_);
    }
}
__device__ __forceinline__ void p5_topk(Ctx& F, int job) {
    const int lane_ = hw_lane(), tid_ = F.wave * 64 + lane_; (void)tid_;
    LAS unsigned* hist = (LAS unsigned*)(F.lds + RING_OFF); LAS unsigned* ctl = hist + 256; LAS unsigned* wsum = hist + 512;
    const int b = job >> 4, e = job & 15;
    const float* AFF = (const float*)(F.ws + WS_AFF) + (size_t)job * LSEQ;
    int* IDX = (int*)(F.ws + WS_IDX); float* GATE = (float*)(F.ws + WS_GATE); int* INV = (int*)(F.ws + WS_INV);
    constexpr int PER = 17;
    unsigned key[PER];
#pragma unroll
    for (int k = 0; k < PER; ++k) { const int i = tid_ * PER + k; key[k] = i < LSEQ ? __float_as_uint(AFF[i]) : 0u; }
    unsigned prefix = 0u, need = CAP;
#pragma unroll 1
    for (int p = 0; p < 4; ++p) {
        const int shift = 24 - 8 * p;
        if (tid_ < 256) hist[tid_] = 0u;
        __syncthreads();
        if (p == 0) {
#pragma unroll
            for (int k = 0; k < PER; ++k) { const int i = tid_ * PER + k; const int bin = i < LSEQ ? (int)(key[k] >> 24) : -1;
                unsigned long long act = __ballot(bin >= 0);
                while (act) { const int leader = __builtin_ctzll(act); const int bl = __builtin_amdgcn_readlane(bin, leader); const unsigned long long m = __ballot(bin == bl);
                    if (lane_ == leader) __hip_atomic_fetch_add(&hist[bl], (unsigned)__builtin_popcountll(m), __ATOMIC_RELAXED, __HIP_MEMORY_SCOPE_WORKGROUP);
                    act &= ~m; } }
        } else {
#pragma unroll
            for (int k = 0; k < PER; ++k) { const int i = tid_ * PER + k;
                if (i < LSEQ && (key[k] >> (shift + 8)) == prefix) __hip_atomic_fetch_add(&hist[(key[k] >> shift) & 255u], 1u, __ATOMIC_RELAXED, __HIP_MEMORY_SCOPE_WORKGROUP); }
        }
        __syncthreads();
        if (F.wave == 0) {
            const unsigned c0 = hist[4 * lane_], c1 = hist[4 * lane_ + 1], c2 = hist[4 * lane_ + 2], c3 = hist[4 * lane_ + 3], s = c0 + c1 + c2 + c3;
            unsigned t = s;
#pragma unroll
            for (int o = 1; o < 64; o <<= 1) { const unsigned v = __shfl_down(t, o); if (lane_ + o < 64) t += v; }
            const unsigned above = t - s;
            if (above < need && need <= t) { unsigned cum = above, sel;
                if (cum + c3 >= need) sel = 3; else { cum += c3; if (cum + c2 >= need) sel = 2; else { cum += c2; if (cum + c1 >= need) sel = 1; else { cum += c1; sel = 0; } } }
                ctl[0] = (prefix << 8) | (4u * lane_ + sel); ctl[1] = need - cum; }
        }
        __syncthreads();
        prefix = ctl[0]; need = ctl[1];
        __syncthreads();
    }
    const unsigned T = prefix, need_eq = need;
    unsigned cnt = 0u;
#pragma unroll
    for (int k = 0; k < PER; ++k) { const int i = tid_ * PER + k; if (i < LSEQ) cnt += (key[k] > T ? 65536u : 0u) + (key[k] == T ? 1u : 0u); }
    unsigned inc = cnt;
#pragma unroll
    for (int o = 1; o < 64; o <<= 1) { const unsigned t = __shfl_up(inc, o); if (lane_ >= o) inc += t; }
    if (lane_ == 63) wsum[F.wave] = inc;
    __syncthreads();
    unsigned base = inc - cnt;
    for (int w = 0; w < F.wave; ++w) base += wsum[w];
    unsigned gt_before = base >> 16, eq_before = base & 65535u;
#pragma unroll
    for (int k = 0; k < PER; ++k) { const int i = tid_ * PER + k;
        if (i < LSEQ) {
            const bool isgt = key[k] > T, iseq = key[k] == T; const bool sel = isgt || (iseq && eq_before < need_eq);
            const int m = i < NMETA ? RMETA + NMETA * b + i : b * SEQ + i - NMETA;
            int yrow = -1;
            if (sel) { const unsigned slot = gt_before + (eq_before < need_eq ? eq_before : need_eq); yrow = e * EPAD + b * CAP + (int)slot; IDX[yrow] = m; GATE[yrow] = __uint_as_float(key[k]); }
            INV[(size_t)m * NEXP + e] = yrow;
            gt_before += isgt ? 1u : 0u; eq_before += iseq ? 1u : 0u;
        } }
    if (b == BATCH - 1) for (int t = tid_; t < EPAD - EROWS; t += 512) { IDX[e * EPAD + EROWS + t] = 0; GATE[e * EPAD + EROWS + t] = 0.f; }
    __syncthreads();
}
__device__ __forceinline__ void p8_final(Ctx& F) {
    const int lane_ = hw_lane(), tid_ = F.wave * 64 + lane_; (void)tid_;
    const int* INV = (const int*)(F.ws + WS_INV); const unsigned char* Y = F.ws + WS_Y; const bf16* H1B = (const bf16*)(F.ws + WS_H1B);
    const float* gsrc = F.in[16]; float gv[16];
#pragma unroll
    for (int j = 0; j < 2; ++j)
#pragma unroll
        for (int i = 0; i < 8; ++i) gv[8 * j + i] = gsrc[8 * lane_ + 512 * j + i];
    for (int g = F.gw; g < RX / 4; g += F.NGW) {
        const int r0 = 4 * g;
        const int iv = INV[(size_t)r0 * NEXP + lane_];
        unsigned long long mask = __ballot(iv >= 0);
        float a[4][16];
#pragma unroll
        for (int q = 0; q < 4; ++q)
#pragma unroll
            for (int j = 0; j < 2; ++j) { const v4u w = *(const GAS v4u*)(H1B + (size_t)(r0 + q) * D + 8 * lane_ + 512 * j);
#pragma unroll
                for (int t = 0; t < 4; ++t) { a[q][8 * j + 2 * t] = bf_lo(w[t]); a[q][8 * j + 2 * t + 1] = bf_hi(w[t]); } }
        while (mask) {
            v2u w[4][2]; float on[4];
#pragma unroll
            for (int q = 0; q < 4; ++q) { const unsigned mq = (unsigned)(mask >> (16 * q)) & 0xffffu; const int e = mq ? __builtin_ctz(mq) : 0;
                const int yrow = __builtin_amdgcn_readlane(iv, 16 * q + e); on[q] = mq ? (1.f / 16.f) : 0.f;
                mask &= ~((unsigned long long)(mq ? 1u : 0u) << (16 * q + e));
                const unsigned char* yp = Y + (size_t)(mq ? yrow : 0) * D + 8 * lane_;
                w[q][0] = *(const GAS v2u*)yp; w[q][1] = *(const GAS v2u*)(yp + 512); }
#pragma unroll
            for (int q = 0; q < 4; ++q)
#pragma unroll
                for (int j = 0; j < 2; ++j)
#pragma unroll
                    for (int t = 0; t < 2; ++t) { typedef float f2_t __attribute__((ext_vector_type(2)));
                        const f2_t lo = __builtin_amdgcn_cvt_pk_f32_fp8((int)w[q][j][t], false), hh = __builtin_amdgcn_cvt_pk_f32_fp8((int)w[q][j][t], true);
                        a[q][8 * j + 4 * t] += on[q] * lo.x; a[q][8 * j + 4 * t + 1] += on[q] * lo.y; a[q][8 * j + 4 * t + 2] += on[q] * hh.x; a[q][8 * j + 4 * t + 3] += on[q] * hh.y; }
        }
#pragma unroll
        for (int q = 0; q < 4; ++q) { float s = 0.f;
#pragma unroll
            for (int i = 0; i < 16; ++i) s += a[q][i] * a[q][i];
            const float rstd = rsqrtf(wave_sum(s) * (1.f / D) + NORM_EPS);
            float* row = F.out + (size_t)(r0 + q) * D + 8 * lane_;
#pragma unroll
            for (int j = 0; j < 2; ++j) { *(GAS f32x4*)(row + 512 * j) = (f32x4){a[q][8 * j] * rstd * gv[8 * j], a[q][8 * j + 1] * rstd * gv[8 * j + 1], a[q][8 * j + 2] * rstd * gv[8 * j + 2], a[q][8 * j + 3] * rstd * gv[8 * j + 3]};
                *(GAS f32x4*)(row + 512 * j + 4) = (f32x4){a[q][8 * j + 4] * rstd * gv[8 * j + 4], a[q][8 * j + 5] * rstd * gv[8 * j + 5], a[q][8 * j + 6] * rstd * gv[8 * j + 6], a[q][8 * j + 7] * rstd * gv[8 * j + 7]}; } }
    }
}
constexpr int NWAVES = 8;
#ifndef MK_N_LAUNCHES
#define MK_N_LAUNCHES 1
#endif
constexpr int N_PHASES = 9;
struct Args { const float* in[17]; float* out; unsigned char* ws; int ph_lo, ph_hi; };
static_assert(sizeof(Args) == 17 * 8 + 8 + 8 + 8, "Args has no padding");

__global__ void __launch_bounds__(NWAVES * 64, 2) hymba_fwd(Args args) {
    extern __shared__ __attribute__((aligned(16))) unsigned char lds_raw[];
    Ctx F;
    F.lds = (LAS unsigned char*)lds_raw;
    F.wave = __builtin_amdgcn_readfirstlane((int)threadIdx.x >> 6);
    F.G = gridDim.x; F.gw = blockIdx.x * NWAVES + F.wave; F.NGW = F.G * NWAVES;
#pragma unroll
    for (int i = 0; i < 17; ++i) F.in[i] = args.in[i];
    F.out = args.out; F.ws = args.ws;
    volatile LAS unsigned* MISC = (volatile LAS unsigned*)(F.lds + MISC_OFF);
    { const int l0 = hw_lane(); if (F.wave == 0) MISC[l0] = 0u; }
    __syncthreads();
    unsigned* ctl = (unsigned*)(F.ws + WS_CTL);
    XcdBarrier bar; bar.bar = ctl + CW_BAR; bar.x = 0; bar.st = nullptr;
    if (MK_N_LAUNCHES == 1) bar = xcd_barrier_post(ctl + CW_BAR, MISC + 8);
    const int lo = args.ph_lo, hi = args.ph_hi;
#define IN(k) (lo <= (k) && (k) < hi)
#define SEAM(k) do { if (IN(k) && IN((k) + 1)) xcd_barrier(bar); } while (0)
#ifndef PROBE_REPEAT
#define PROBE_REPEAT -1
#endif
#define REP(k) for (int rep_ = 0; rep_ < ((PROBE_REPEAT == (k)) ? 2 : 1); ++rep_)
#define REPBAR(k) do { if (PROBE_REPEAT == (k) && rep_ == 0) xcd_barrier(bar); } while (0)

    if (IN(0)) { REP(0) { p0_prologue(F); REPBAR(0); } SEAM(0); }

    if (IN(1)) {
        pg8::Gemm g{(const pg8::bf16_t*)(F.ws + WS_XN), (const pg8::bf16_t*)(F.ws + WS_WIN), D};
        pg8::StaticOrder S; S.init(RX / 256, NPROJ / 256, F.G, (int)blockIdx.x);
        pg8::EpiInProj E{(pg8::bf16_t*)(F.ws + WS_Q), (pg8::bf16_t*)(F.ws + WS_K), (pg8::bf16_t*)(F.ws + WS_V), (pg8::bf16_t*)(F.ws + WS_U), (pg8::bf16_t*)(F.ws + WS_CB),
                         (const float*)(F.ws + WS_ROPE), (const float*)(F.ws + WS_ROPE) + LSEQ * 32, ctl + CW_KMAX};
        pg8::RowIdentity AM;
        REP(1) { pg8::gemm_phase<pg8::EpiInProj, pg8::StaticOrder, pg8::RowIdentity, true>(F.lds + RING_OFF, g, S, E, AM, F.wave); REPBAR(1); }
        for (int pn = (int)blockIdx.x; pn < NPROJ / 256; pn += F.G) {
            pg8::ThinAcc T; const int l0 = hw_lane();
            pg8::thin_gemm<false>(F.ws + WS_XN, F.ws + WS_WIN, D * 2, pn, [](int fr) { return RX + fr; }, F.wave, l0, T, 0);
            pg8::thin_epi_inproj(T, pn, F.wave, l0, E.Q, E.Kb, E.V, E.U, E.CB, E.rcos, E.rsin, E.kmax); }
        SEAM(1);
    }

    if (IN(2)) {
        float lam;
        { const int l0 = hw_lane(); const float a = F.in[5][l0] * F.in[6][l0], b2 = F.in[7][l0] * F.in[8][l0];
          lam = expf(wave_sum(a)) - expf(wave_sum(b2)) + LAM_INIT; }
        const att::Tensors T{(const att::bf16_t*)(F.ws + WS_Q), (const att::bf16_t*)(F.ws + WS_K), (const att::bf16_t*)(F.ws + WS_V), (att::bf16_t*)(F.ws + WS_XN), F.in[9], lam, (const float*)(ctl + CW_KMAX)};
        const int c = (int)blockIdx.x;
        float* const parts = (float*)(F.ws + WS_PART);
        REP(2) { for (int i = 0;; ++i) {
            int b, h, qrow0, nvalid, tb = 0, te = att::NTILE; float* part = nullptr;
            if (F.G == 256) {
                const int xcd = c & 7, ci = c >> 3;
                if (i < 8) { const int bh = xcd + 8 * (i >> 1); b = bh >> 2; h = bh & 3; qrow0 = b * SEQ + ((i & 1) * 32 + ci) * 128; nvalid = 128; }
                else if (i == 8 && ci < 4 * att::META_CHUNKS) { const int bh = xcd + 8 * (ci / att::META_CHUNKS), ch = ci % att::META_CHUNKS; b = bh >> 2; h = bh & 3; qrow0 = RMETA + NMETA * b; nvalid = NMETA;
                    att::meta_chunk(ch, tb, te); part = parts + (size_t)(bh * att::META_CHUNKS + ch) * 2 * att::PART_F32; }
                else break;
            } else {
                const long L = (long)i * F.G + c;
                if (L < 2048) { const int bh = (int)(L >> 6); b = bh >> 2; h = bh & 3; qrow0 = b * SEQ + (int)(L & 63) * 128; nvalid = 128; }
                else if (L < 2048 + 32 * att::META_CHUNKS) { const int j = (int)(L - 2048), bh = j / att::META_CHUNKS, ch = j % att::META_CHUNKS; b = bh >> 2; h = bh & 3; qrow0 = RMETA + NMETA * b; nvalid = NMETA;
                    att::meta_chunk(ch, tb, te); part = parts + (size_t)(bh * att::META_CHUNKS + ch) * 2 * att::PART_F32; }
                else break;
            }
            att::attn_unit<8>(T, b, h, qrow0, nvalid, tb, te, part, (ALAS char*)(F.lds + RING_OFF), F.wave);
        } REPBAR(2); }
        REP(20) { conv_rows(F); REPBAR(20); }
        if (IN(3)) xcd_barrier(bar);
        if (F.gw < 32) att::meta_combine(T, parts, F.gw, hw_lane());
        SEAM(2);
    }

    if (IN(3)) {
        pg8::Gemm g{(const pg8::bf16_t*)(F.ws + WS_XN), (const pg8::bf16_t*)(F.ws + WS_WOUT), D};
        pg8::StaticOrder S; S.init(RX / 256, D / 256, F.G, (int)blockIdx.x);
        pg8::EpiOutProj E{F.in[0], F.in[1], (pg8::bf16_t*)(F.ws + WS_H1B), (float*)(F.ws + WS_H1M)};
        pg8::RowIdentity AM;
        REP(3) { pg8::gemm_phase<pg8::EpiOutProj, pg8::StaticOrder, pg8::RowIdentity, true>(F.lds + RING_OFF, g, S, E, AM, F.wave); REPBAR(3); }
        for (int i = (int)blockIdx.x; i < BATCH * (D / 256); i += F.G) {
            pg8::ThinAcc T; const int l0 = hw_lane(), b = i >> 2, pn = i & 3;
            pg8::thin_gemm<false>(F.ws + WS_XN, F.ws + WS_WOUT, D * 2, pn, [b](int fr) { return RX + NMETA * b + fr; }, F.wave, l0, T, 0);
            pg8::thin_epi_outproj(T, b, pn, F.wave, l0, F.in[1], (float*)(F.ws + WS_H1M)); }
        SEAM(3);
    }

    if (IN(4)) { REP(4) { p4_norm_router(F); REPBAR(4); } SEAM(4); }

    if (IN(5)) { REP(5) { for (int job = (int)blockIdx.x; job < BATCH * NEXP; job += F.G) p5_topk(F, job); REPBAR(5); } SEAM(5); }

    if (IN(6)) {
        pg8::Gemm g{(const pg8::bf16_t*)(F.ws + WS_HN2), (const pg8::bf16_t*)(F.ws + WS_W1), D / 2};
        pg8::ExpertOrder S; S.init(16, F.G, (int)blockIdx.x);
        pg8::EpiSwiglu E{F.ws + WS_H};
        pg8::RowGather AM{(const int*)(F.ws + WS_IDX)};
        const bool thin_first_ = (((int)blockIdx.x >> 3) & 1) != 0;
        { const bool thin_pass_ = thin_first_;
        for (int i = (int)blockIdx.x; i < NEXP * 16 && thin_pass_; i += F.G) {
            const int e = (F.G == 256) ? 2 * (i & 7) + (i >> 7) : i >> 4, ct = (F.G == 256) ? (i >> 3) & 15 : i & 15;
            pg8::ThinAcc T; const int l0 = hw_lane(); const int* idx = (const int*)(F.ws + WS_IDX) + e * EPAD + 32 * 256;
            pg8::thin_gemm<true>(F.ws + WS_HN2, F.ws + WS_W1, D, e * 16 + ct, [idx](int fr) { return idx[fr]; }, F.wave, l0, T, pg8::EpiSwiglu::WSCALE);
            pg8::thin_epi_swiglu(T, e, ct, F.wave, l0, F.ws + WS_H); }
        }
        REP(6) { pg8::gemm_phase<pg8::EpiSwiglu, pg8::ExpertOrder, pg8::RowGather, true, true>(F.lds + RING_OFF, g, S, E, AM, F.wave); REPBAR(6); }
        { const bool thin_pass_ = !thin_first_;
        for (int i = (int)blockIdx.x; i < NEXP * 16 && thin_pass_; i += F.G) {
            const int e = (F.G == 256) ? 2 * (i & 7) + (i >> 7) : i >> 4, ct = (F.G == 256) ? (i >> 3) & 15 : i & 15;
            pg8::ThinAcc T; const int l0 = hw_lane(); const int* idx = (const int*)(F.ws + WS_IDX) + e * EPAD + 32 * 256;
            pg8::thin_gemm<true>(F.ws + WS_HN2, F.ws + WS_W1, D, e * 16 + ct, [idx](int fr) { return idx[fr]; }, F.wave, l0, T, pg8::EpiSwiglu::WSCALE);
            pg8::thin_epi_swiglu(T, e, ct, F.wave, l0, F.ws + WS_H); }
        }
        SEAM(6);
    }

    if (IN(7)) {
        pg8::Gemm g{(const pg8::bf16_t*)(F.ws + WS_H), (const pg8::bf16_t*)(F.ws + WS_W2), FF / 2};
        pg8::ExpertOrder S; S.init(4, F.G, (int)blockIdx.x);
        pg8::EpiDown E{F.ws + WS_Y, (const float*)(F.ws + WS_GATE)};
        pg8::RowIdentity AM;
        REP(7) { pg8::gemm_phase<pg8::EpiDown, pg8::ExpertOrder, pg8::RowIdentity, true, true>(F.lds + RING_OFF, g, S, E, AM, F.wave); REPBAR(7); }
        for (int i = (int)blockIdx.x; i < NEXP * 4; i += F.G) {
            const int e = (F.G == 256) ? 2 * (i & 7) + (i >> 5) : i >> 2, ct = (F.G == 256) ? (i >> 3) & 3 : i & 3;
            pg8::ThinAcc T; const int l0 = hw_lane();
            pg8::thin_gemm<true>(F.ws + WS_H, F.ws + WS_W2, FF, e * 4 + ct, [e](int fr) { return e * EPAD + 32 * 256 + fr; }, F.wave, l0, T, pg8::EpiDown::WSCALE);
            pg8::thin_epi_down(T, e, ct, F.wave, l0, F.ws + WS_Y, (const float*)(F.ws + WS_GATE)); }
        SEAM(7);
    }

    if (IN(8)) { p8_final(F); }
#undef IN
#undef SEAM
}

extern "C" void kernel_launch(void* const* d_in, const int* in_sizes, int n_in, void* d_out, int out_size, void* d_ws, size_t ws_size, hipStream_t stream) {
    static int grid = 0;
    if (grid == 0) {
        if (n_in != 17 || out_size != RX * D || ws_size < WS_END) { fprintf(stderr, "kernel_launch: unexpected shapes (n_in %d, out %d, ws %zu < %zu)\n", n_in, out_size, ws_size, (size_t)WS_END); grid = -1; return; }
        int dev = 0, cus = 0, per_cu = 0;
        if (hipGetDevice(&dev) != hipSuccess || hipDeviceGetAttribute(&cus, hipDeviceAttributeMultiprocessorCount, dev) != hipSuccess) { grid = -1; return; }
        if (hipFuncSetAttribute((const void*)hymba_fwd, hipFuncAttributeMaxDynamicSharedMemorySize, LDS_BYTES) != hipSuccess) { fprintf(stderr, "kernel_launch: hipFuncSetAttribute failed\n"); grid = -1; return; }
        if (hipOccupancyMaxActiveBlocksPerMultiprocessor(&per_cu, (const void*)hymba_fwd, NWAVES * 64, LDS_BYTES) != hipSuccess || per_cu < 1) { fprintf(stderr, "kernel_launch: occupancy query says %d\n", per_cu); }
        (void)hipGetLastError();
        grid = cus;
    }
    if (grid < 0) return;
    (void)in_sizes;
    if (hipMemsetAsync((char*)d_ws + WS_CTL, 0, CTL_ZERO_BYTES, stream) != hipSuccess) return;
    Args a{};
    for (int i = 0; i < 17; ++i) a.in[i] = (const float*)d_in[i];
    a.out = (float*)d_out; a.ws = (unsigned char*)d_ws;
    if (MK_N_LAUNCHES == 1) { a.ph_lo = 0; a.ph_hi = N_PHASES; hipLaunchKernelGGL(hymba_fwd, dim3(grid), dim3(NWAVES * 64), LDS_BYTES, stream, a); }
    else for (int p = 0; p < N_PHASES; ++p) { a.ph_lo = p; a.ph_hi = p + 1; hipLaunchKernelGGL(hymba_fwd, dim3(grid), dim3(NWAVES * 64), LDS_BYTES, stream, a); }
}
```

```cpp
#include <hip/hip_runtime.h>
#include <cstdio>
#include <cstdint>
#include <cmath>
__device__ __forceinline__ int hw_lane() { int l; asm volatile("v_mbcnt_lo_u32_b32 %0, -1, 0\n\tv_mbcnt_hi_u32_b32 %0, -1, %0" : "=v"(l)); return l; }
namespace pg8 {
#define PG8_LAS __attribute__((address_space(3)))
typedef unsigned short bf16_t;
typedef short bf16x8 __attribute__((ext_vector_type(8)));
typedef float f32x4 __attribute__((ext_vector_type(4)));
typedef unsigned u32x4 __attribute__((ext_vector_type(4)));
typedef int v4i_t __attribute__((ext_vector_type(4)));
typedef int v8i_t __attribute__((ext_vector_type(8)));
constexpr int BM = 256, BK = 64, HALF = 128, HTB = HALF * BK * 2  , STAGE_BYTES = 8 * HTB, NXCD = 8, WGM = 4;

__host__ __device__ __forceinline__ int lds_byte(int r, int c) { const int st = (r >> 4) * 2 + (c >> 5), rr = r & 15, cc = c & 31, ob = rr * 64 + cc * 2; return st * 1024 + (ob ^ (((ob >> 9) & 1) << 5)); }
__host__ __device__ __forceinline__ void stage_rc(int b, int& R, int& C) { const int st = b / 1024, sb = b % 1024, swz = sb ^ (((sb >> 9) & 1) << 5); R = (st >> 1) * 16 + swz / 64; C = (st & 1) * 32 + (swz % 64) / 2; }
__host__ __device__ __forceinline__ int perm32(int rho) { const int n = rho >> 4, i = rho & 15; return 8 * (i >> 2) + 4 * n + (i & 3); }

struct Unit { int pm, pn; };
struct Gemm { const bf16_t* A; const bf16_t* Bt; int K; };

struct StaticOrder {
    int nM, nN, nwg, G, c;
    __host__ __device__ void init(int nM_, int nN_, int G_, int c_) { nM = nM_; nN = nN_; nwg = nM * nN; G = G_; c = c_; }
    __host__ __device__ bool next(int i, Unit& u) const {
        const long L = (long)i * G + c; if (L >= nwg) return false;
        int wgid = (int)L; { const int q = nwg / NXCD, r = nwg % NXCD, xcd = wgid % NXCD, off = wgid / NXCD; wgid = (xcd < r ? xcd * (q + 1) : r * (q + 1) + (xcd - r) * q) + off; }
        const int nig = WGM * nN, gid = wgid / nig, fm = gid * WGM, gsz = (nM - fm) < WGM ? (nM - fm) : WGM;
        u.pm = fm + ((wgid % nig) % gsz); u.pn = (wgid % nig) / gsz; return true;
    }
};
struct ExpertOrder {
    int NT, G, c;
    __host__ __device__ void init(int NT_, int G_, int c_) { NT = NT_; G = G_; c = c_; }
    __host__ __device__ bool next(int i, Unit& u) const {
        const int per = 32 * NT;
        int e, jj;
        if (G == 256) { const int xcd = c & 7, ci = c >> 3, j = i * 32 + ci; if (j >= 2 * per) return false; e = 2 * xcd + j / per; jj = j % per; }
        else { const long L = (long)i * G + c; if (L >= 16L * per) return false; e = (int)(L / per); jj = (int)(L % per); }
        const int blk = 8 * NT, rgp = jj / blk, w = jj % blk, cg = w >> 5, v = w & 31; const int rt = 8 * rgp + (v & 7), ct = cg * 4 + (v >> 3);
        u.pm = e * 33 + rt; u.pn = e * NT + ct; return true;
    }
};
struct RowIdentity { __device__ __forceinline__ unsigned row(int pm, int h, int R) const { return (unsigned)(pm * BM + h * HALF + R); } };
struct RowGather { const int* idx; __device__ __forceinline__ unsigned row(int pm, int h, int R) const { return (unsigned)idx[pm * BM + h * HALF + R]; } };

__device__ __forceinline__ unsigned cvt_pk_bf16(float lo, float hi) { unsigned r; asm volatile("v_cvt_pk_bf16_f32 %0, %1, %2" : "=v"(r) : "v"(lo), "v"(hi)); return r; }
__device__ __forceinline__ u32x4 pack8(const f32x4 v0, const f32x4 v1) { u32x4 w; w.x = cvt_pk_bf16(v0[0], v0[1]); w.y = cvt_pk_bf16(v0[2], v0[3]); w.z = cvt_pk_bf16(v1[0], v1[1]); w.w = cvt_pk_bf16(v1[2], v1[3]); return w; }


template <class Epi, class Sched, class AMap, bool ALIGN_EPI, bool FP8 = false>
__device__ __forceinline__ void gemm_phase(PG8_LAS unsigned char* lds, const Gemm g, const Sched& S, const Epi& E, const AMap& AM, const int wid) {
    const int lane = hw_lane(), tid = wid * 64 + lane, wr = wid >> 2, wc = wid & 3, fr = lane & 15, fq = lane >> 4;
    const int K = g.K, nt = K / BK;
    unsigned voffB[2];
#pragma unroll
    for (int i = 0; i < 2; ++i) { int R, C; stage_rc(tid * 16 + i * 8192, R, C); const int Rb = Epi::PERM ? ((R & ~31) + perm32(R & 31)) : R;
        voffB[i] = (unsigned)(Rb * K + C) * 2u; }
    const size_t kstep = (size_t)(BK * 2);
    const size_t hstep = (size_t)HALF * K * 2;
    const size_t tstep = 2 * hstep;
    const unsigned ldsw = (unsigned)wid * 1024u;
    const int aoff = lds_byte(wr * 64 + fr, fq * 8), boff = lds_byte(wc * 32 + fr, fq * 8);
#define PG8_SA(b, h) (((b) * 2 + (h)) * HTB)
#define PG8_SB(b, h) ((4 + (b) * 2 + (h)) * HTB)
#define PG8_STAGE(bufoff, gbase, voff) do { _Pragma("unroll") for (int _i = 0; _i < 2; ++_i) \
        __builtin_amdgcn_global_load_lds((const unsigned*)((const char*)(gbase) + (voff)[_i]), (PG8_LAS unsigned*)(lds + (bufoff) + ldsw + _i * 8192), 16, 0, 0); } while (0)
#define PG8_LD8(p) __builtin_shufflevector(*(const PG8_LAS v4i_t*)(p), *(const PG8_LAS v4i_t*)((p) + 1024), 0, 1, 2, 3, 4, 5, 6, 7)
#define PG8_LDA(dst, b, h) do { if constexpr (FP8) { _Pragma("unroll") for (int m = 0; m < 4; ++m) dst##8[m] = PG8_LD8(lds + PG8_SA(b, h) + aoff + m * 2048); } \
        else { _Pragma("unroll") for (int m = 0; m < 4; ++m) _Pragma("unroll") for (int k = 0; k < 2; ++k) dst[m][k] = *(const PG8_LAS bf16x8*)(lds + PG8_SA(b, h) + aoff + m * 2048 + k * 1024); } } while (0)
#define PG8_LDB(dst, b, h) do { if constexpr (FP8) { _Pragma("unroll") for (int n = 0; n < 2; ++n) dst##8[n] = PG8_LD8(lds + PG8_SB(b, h) + boff + n * 2048); } \
        else { _Pragma("unroll") for (int n = 0; n < 2; ++n) _Pragma("unroll") for (int k = 0; k < 2; ++k) dst[n][k] = *(const PG8_LAS bf16x8*)(lds + PG8_SB(b, h) + boff + n * 2048 + k * 1024); } } while (0)
#define PG8_MMA(ai, bj, At, Bt) do { __builtin_amdgcn_s_setprio(1); \
        if constexpr (FP8) { _Pragma("unroll") for (int m = 0; m < 4; ++m) _Pragma("unroll") for (int n = 0; n < 2; ++n) \
            asm volatile("v_mfma_scale_f32_16x16x128_f8f6f4 %0, %1, %2, %0, %3, %4 op_sel_hi:[0,0,0]" : "+v"(acc[ai][bj][m][n]) : "v"(Bt##8[n]), "v"(At##8[m]), "v"(wscale_), "v"(ascale_)); } \
        else { _Pragma("unroll") for (int m = 0; m < 4; ++m) _Pragma("unroll") for (int n = 0; n < 2; ++n) _Pragma("unroll") for (int k = 0; k < 2; ++k) \
            acc[ai][bj][m][n] = __builtin_amdgcn_mfma_f32_16x16x32_bf16(Bt[n][k], At[m][k], acc[ai][bj][m][n], 0, 0, 0); } \
        __builtin_amdgcn_s_setprio(0); } while (0)
#define PG8_WAIT_V(n) asm volatile("s_waitcnt vmcnt(" #n ")" ::: "memory")
#define PG8_WAIT_L(n) asm volatile("s_waitcnt lgkmcnt(" #n ")" ::: "memory")
#define PG8_BAR __builtin_amdgcn_s_barrier()
#define PG8_SCHED __builtin_amdgcn_sched_barrier(0)
#define PG8_ARAW(dst, u_) do { _Pragma("unroll") for (int _h = 0; _h < 2; ++_h) _Pragma("unroll") for (int _i = 0; _i < 2; ++_i) { int R_, C_; stage_rc(tid * 16 + _i * 8192, R_, C_); dst[_h][_i] = AM.row((u_).pm, _h, R_); } } while (0)
#define PG8_AOFS(dst, raw) do { _Pragma("unroll") for (int _h = 0; _h < 2; ++_h) _Pragma("unroll") for (int _i = 0; _i < 2; ++_i) { int R_, C_; stage_rc(tid * 16 + _i * 8192, R_, C_); dst[_h][_i] = (raw[_h][_i] * (unsigned)K + (unsigned)C_) * 2u; } } while (0)
    Unit cur, nxt; int ui = 0;
    if (!S.next(0, cur)) return;
    f32x4 acc[2][2][4][2];
#pragma unroll
    for (int a = 0; a < 2; ++a)
#pragma unroll
        for (int b = 0; b < 2; ++b)
#pragma unroll
            for (int m = 0; m < 4; ++m)
#pragma unroll
                for (int n = 0; n < 2; ++n) acc[a][b][m][n] = (f32x4){0.f, 0.f, 0.f, 0.f};
    const int wscale_ = Epi::WSCALE, ascale_ = 0x7f7f7f7f;
    bf16x8 At[4][2], B0[2][2], B1[2][2]; v8i_t At8[4], B08[2], B18[2];
    unsigned voA[2][2], rawN[2][2];
    PG8_ARAW(rawN, cur); PG8_AOFS(voA, rawN);
    const char* const Ab = (const char*)g.A;
    const char* cB = (const char*)g.Bt + (size_t)cur.pn * tstep;
    PG8_STAGE(PG8_SB(0, 0), cB, voffB); PG8_STAGE(PG8_SB(0, 1), cB + hstep, voffB); PG8_STAGE(PG8_SA(0, 0), Ab, voA[0]); PG8_STAGE(PG8_SA(0, 1), Ab, voA[1]);
    if (wr == 1) PG8_BAR;
    PG8_WAIT_V(2); PG8_BAR;
    PG8_STAGE(PG8_SB(1, 0), cB + kstep, voffB); PG8_STAGE(PG8_SA(1, 0), Ab + kstep, voA[0]); PG8_STAGE(PG8_SB(1, 1), cB + hstep + kstep, voffB);
    PG8_WAIT_V(6); PG8_BAR;
    for (;;) {
        const bool has_next = S.next(ui + 1, nxt);
        if (has_next) { PG8_ARAW(rawN, nxt); }
        const char* nB = has_next ? (const char*)g.Bt + (size_t)nxt.pn * tstep : cB;
#pragma unroll 1
        for (int t = 0; t < nt; t += 2) {
            const bool last = (t == nt - 2);
            const char* a1 = Ab + (size_t)(t + 1) * kstep;
            const char* a2 = last ? Ab : Ab + (size_t)(t + 2) * kstep; const char* b2 = last ? nB : cB + (size_t)(t + 2) * kstep;
            const char* a3 = a2 + kstep; const char* b3 = b2 + kstep;
            unsigned v2[2][2];
            if (last) { asm volatile("" ::: "memory"); PG8_AOFS(v2, rawN); }
            else {
#pragma unroll
                for (int _h = 0; _h < 2; ++_h)
#pragma unroll
                    for (int _i = 0; _i < 2; ++_i) v2[_h][_i] = voA[_h][_i]; }
            PG8_LDB(B0, 0, 0); PG8_LDB(B1, 0, 1); PG8_SCHED; PG8_LDA(At, 0, 0); PG8_STAGE(PG8_SA(1, 1), a1, voA[1]);
            PG8_WAIT_V(8); PG8_WAIT_L(0); PG8_BAR; PG8_MMA(0, 0, At, B0); PG8_MMA(0, 1, At, B1); PG8_BAR; PG8_SCHED;
            PG8_LDA(At, 0, 1); PG8_STAGE(PG8_SB(0, 0), b2, voffB); PG8_STAGE(PG8_SB(0, 1), b2 + hstep, voffB); PG8_STAGE(PG8_SA(0, 0), a2, v2[0]);
            PG8_WAIT_V(8); PG8_WAIT_L(0); PG8_BAR; PG8_MMA(1, 0, At, B0); PG8_MMA(1, 1, At, B1); PG8_BAR; PG8_SCHED;
            PG8_LDB(B0, 1, 0); PG8_LDB(B1, 1, 1); PG8_SCHED; PG8_LDA(At, 1, 0); PG8_STAGE(PG8_SA(0, 1), a2, v2[1]);
            PG8_WAIT_V(8); PG8_WAIT_L(0); PG8_BAR; PG8_MMA(0, 0, At, B0); PG8_MMA(0, 1, At, B1); PG8_BAR; PG8_SCHED;
            PG8_LDA(At, 1, 1); PG8_STAGE(PG8_SB(1, 0), b3, voffB); PG8_STAGE(PG8_SB(1, 1), b3 + hstep, voffB); PG8_STAGE(PG8_SA(1, 0), a3, v2[0]);
            PG8_WAIT_V(8); PG8_WAIT_L(0); PG8_BAR; PG8_MMA(1, 0, At, B0); PG8_MMA(1, 1, At, B1); PG8_BAR; PG8_SCHED;
        }
        if constexpr (ALIGN_EPI) { if (wr == 0) PG8_BAR; }
        if constexpr (FP8) asm volatile("s_nop 15\n\ts_nop 15" ::: "memory");
        E(acc, cur, wr, wc, fr, fq);
        if (!has_next) break;
#pragma unroll
        for (int a = 0; a < 2; ++a)
#pragma unroll
            for (int b = 0; b < 2; ++b)
#pragma unroll
                for (int m = 0; m < 4; ++m)
#pragma unroll
                    for (int n = 0; n < 2; ++n) acc[a][b][m][n] = (f32x4){0.f, 0.f, 0.f, 0.f};
        cur = nxt; cB = nB; ++ui;
        PG8_AOFS(voA, rawN);
        if constexpr (ALIGN_EPI) { if (wr == 1) PG8_BAR; }
    }
    PG8_WAIT_V(0);
    if constexpr (!ALIGN_EPI) { if (wr == 0) PG8_BAR; }
    PG8_BAR;
#undef PG8_SA
#undef PG8_SB
#undef PG8_STAGE
#undef PG8_LDA
#undef PG8_LDB
#undef PG8_MMA
#undef PG8_LD8
#undef PG8_WAIT_V
#undef PG8_WAIT_L
#undef PG8_BAR
#undef PG8_SCHED
#undef PG8_ARAW
#undef PG8_AOFS
}
}
constexpr int D = 1024, BATCH = 8, SEQ = 8192, NMETA = 16, LSEQ = SEQ + NMETA;
constexpr int RX = BATCH * SEQ;
constexpr int RMETA = RX;
constexpr int RV = RX + BATCH * NMETA;
constexpr int RP = 257 * 256;
constexpr int AW = 512, CWID = 512, NPROJ = 3072;
constexpr int NEXP = 16, CAP = 1026, FF = 2048;
constexpr int EROWS = BATCH * CAP;
constexpr int EPAD = 33 * 256;
constexpr int KV_TILES = 129;
constexpr float NORM_EPS = 1e-6f;
constexpr float LAM_INIT = 0.2f;
constexpr float C2 = 0.125f * 1.4426950408889634f;

namespace pg8 {
template <bool SKIP = false> struct EpiInProjT {
    static constexpr bool PERM = true; static constexpr int WSCALE = 0x7f7f7f7f;
    bf16_t *Q, *Kb, *V, *U, *CB; const float* rcos; const float* rsin;
    unsigned* kmax;
    __device__ __forceinline__ void operator()(const f32x4 (&acc)[2][2][4][2], const Unit& u_in, int wr, int wc, int fr_, int fq_) const {
        const int l_ = hw_lane(), fr = l_ & 15, fq = l_ >> 4; (void)fr_; (void)fq_;
        const Unit& u = u_in;
        const int row0 = u.pm * BM + wr * 64 + fr; const int pn = u.pn;
        const bool xt = u.pm < RX / BM;
        if (pn < 4) {
            const int sh = (pn & 1) * 4 + wc;
            const float* rc0 = rcos + (xt ? NMETA + (u.pm & 31) * 256 + wr * 64 + fr : fr) * 32 + 8 * fq; const float* rs0 = rc0 + (rsin - rcos);
            const float sc = pn < 2 ? C2 : 1.0f;
            bf16_t* p0; int st_ai, st_m;
            if (pn < 2) { p0 = Q + (size_t)row0 * AW + sh * 64 + 8 * fq; st_ai = HALF * AW; st_m = 16 * AW; }
            else if (xt) { p0 = Kb + ((size_t)(((u.pm >> 5) * 8 + sh) * KV_TILES + 1 + (u.pm & 31) * 4 + wr)) * 4096 + fq * 512 + (16 * (fr >> 2) + 4 * ((fr >> 1) & 1) + 8 * (fr & 1)) * 8; st_ai = 2 * 4096; st_m = 8; }
            else { p0 = Kb + ((size_t)((wr * 4 * 8 + sh) * KV_TILES)) * 4096 + fq * 512 + fr * 8; st_ai = 0; st_m = 8 * KV_TILES * 4096; }
            const int o2 = pn < 2 ? 32 : 2048;
            f32x4 cb0 = *(const f32x4*)rc0, cb1 = *(const f32x4*)(rc0 + 4), sb0 = *(const f32x4*)rs0, sb1 = *(const f32x4*)(rs0 + 4);
            f32x4 cA0 = (f32x4){1.f, 1.f, 1.f, 1.f}, cA1 = cA0, sA0 = (f32x4){0.f, 0.f, 0.f, 0.f}, sA1 = sA0;
            if (xt) { cA0 = *(const f32x4*)(rcos + 16 * 32 + 8 * fq); cA1 = *(const f32x4*)(rcos + 16 * 32 + 8 * fq + 4); sA0 = *(const f32x4*)(rsin + 16 * 32 + 8 * fq); sA1 = *(const f32x4*)(rsin + 16 * 32 + 8 * fq + 4); }
            float ksq = 0.f;
#pragma unroll
            for (int ai = 0; ai < 2; ++ai) {
                if (!xt && ai == 1 && pn >= 2) break;
                f32x4 c0 = cb0, c1 = cb1, s0 = sb0, s1 = sb1;
#pragma unroll
                for (int m = 0; m < 4; ++m) {
                    const f32x4 x10 = acc[ai][0][m][0], x11 = acc[ai][0][m][1], x20 = acc[ai][1][m][0], x21 = acc[ai][1][m][1];
                    const f32x4 a0 = (x10 * c0 - x20 * s0) * sc, a1 = (x11 * c1 - x21 * s1) * sc, b0 = (x20 * c0 + x10 * s0) * sc, b1 = (x21 * c1 + x11 * s1) * sc;
                    bf16_t* p = p0 + (size_t)ai * st_ai + (size_t)m * st_m;
                    *(u32x4*)p = pack8(a0, a1); *(u32x4*)(p + o2) = pack8(b0, b1);
                    if (pn >= 2) { const f32x4 q_ = a0 * a0 + a1 * a1 + b0 * b0 + b1 * b1; float ps_ = (q_[0] + q_[1]) + (q_[2] + q_[3]);
                        ps_ += __shfl_xor(ps_, 16); ps_ += __shfl_xor(ps_, 32); ksq = fmaxf(ksq, ps_); }
                    if (m < 3) { const f32x4 n0 = c0 * cA0 - s0 * sA0, n1 = c1 * cA1 - s1 * sA1; s0 = s0 * cA0 + c0 * sA0; s1 = s1 * cA1 + c1 * sA1; c0 = n0; c1 = n1; } }
                if (ai == 0 && xt) { const f32x4 cB0 = *(const f32x4*)(rcos + 128 * 32 + 8 * fq), cB1 = *(const f32x4*)(rcos + 128 * 32 + 8 * fq + 4), sB0 = *(const f32x4*)(rsin + 128 * 32 + 8 * fq), sB1 = *(const f32x4*)(rsin + 128 * 32 + 8 * fq + 4);
                    const f32x4 n0 = cb0 * cB0 - sb0 * sB0, n1 = cb1 * cB1 - sb1 * sB1; sb0 = sb0 * cB0 + cb0 * sB0; sb1 = sb1 * cB1 + cb1 * sB1; cb0 = n0; cb1 = n1; }
            }
            if (pn >= 2 && xt) {
#pragma unroll
                for (int m_ = 1; m_ < 16; m_ <<= 1) ksq = fmaxf(ksq, __shfl_xor(ksq, m_));
                if (l_ == 0) { const unsigned old_ = __hip_atomic_fetch_max(kmax + (u.pm >> 5) * 8 + sh, __float_as_uint(ksq * 1.02f), __ATOMIC_RELAXED, __HIP_MEMORY_SCOPE_AGENT); asm volatile("" :: "v"(old_)); } }
        } else if (pn < 6) {
            if (xt) {
                unsigned char* p0 = (unsigned char*)V + ((size_t)(((u.pm >> 5) * 4 + (pn - 4) * 2) * KV_TILES + 1 + (u.pm & 31) * 4 + wr)) * 8192 + wc * 2048
                                    + ((fr >> 1) & 1) * 1024 + (fr >> 3) * 512 + fq * 128 + (2 * ((fr >> 2) & 1) + (fr & 1)) * 4;
#pragma unroll
                for (int ai = 0; ai < 2; ++ai)
#pragma unroll
                    for (int bj = 0; bj < 2; ++bj)
#pragma unroll
                        for (int n = 0; n < 2; ++n)
#pragma unroll
                            for (int i = 0; i < 4; ++i) { int w_ = __builtin_amdgcn_cvt_pk_fp8_f32(16.f * acc[ai][bj][0][n][i], 16.f * acc[ai][bj][1][n][i], 0, false);
                                w_ = __builtin_amdgcn_cvt_pk_fp8_f32(16.f * acc[ai][bj][2][n][i], 16.f * acc[ai][bj][3][n][i], w_, true);
                                *(int*)(p0 + (size_t)ai * (2 * 8192) + (size_t)bj * KV_TILES * 8192 + (4 * n + i) * 16) = w_; }
            }
        } else if (pn < 10) {
            const int colb = (pn - 6) * 128 + wc * 32 + 8 * fq;
#pragma unroll
            for (int ai = 0; ai < 2; ++ai)
#pragma unroll
                for (int m = 0; m < 4; ++m) { bf16_t* p = U + (size_t)(row0 + ai * HALF + m * 16) * CWID + colb;
                    *(u32x4*)p = pack8(acc[ai][0][m][0] * acc[ai][1][m][0], acc[ai][0][m][1] * acc[ai][1][m][1]); }
        } else {
            const int colb = (pn - 10) * 256 + wc * 32 + 8 * fq;
#pragma unroll
            for (int ai = 0; ai < 2; ++ai)
#pragma unroll
                for (int m = 0; m < 4; ++m) { bf16_t* p = CB + (size_t)(row0 + ai * HALF + m * 16) * CWID + colb;
#pragma unroll
                    for (int bj = 0; bj < 2; ++bj) *(u32x4*)(p + bj * HALF) = pack8(acc[ai][bj][m][0], acc[ai][bj][m][1]); }
        }
    }
};
typedef EpiInProjT<false> EpiInProj;
struct EpiOutProj {
    static constexpr bool PERM = true; static constexpr int WSCALE = 0x7f7f7f7f;
    const float* x; const float* meta; bf16_t* h1b; float* h1meta;
    __device__ __forceinline__ void operator()(const f32x4 (&acc)[2][2][4][2], const Unit& u, int wr, int wc, int fr, int fq) const {
        const int col0 = u.pn * BM + wc * 32 + 8 * fq;
        if (u.pm < RX / BM) {
#pragma unroll
            for (int ai = 0; ai < 2; ++ai)
#pragma unroll
                for (int m = 0; m < 4; ++m) { const size_t off = (size_t)(u.pm * BM + ai * HALF + wr * 64 + m * 16 + fr) * D + col0;
#pragma unroll
                    for (int bj = 0; bj < 2; ++bj) { const f32x4 b0 = *(const f32x4*)(x + off + bj * HALF), b1 = *(const f32x4*)(x + off + bj * HALF + 4);
                        *(u32x4*)(h1b + off + bj * HALF) = pack8(b0 + acc[ai][bj][m][0], b1 + acc[ai][bj][m][1]); } }
        } else {
#pragma unroll
            for (int m = 0; m < 4; ++m) { const int rr = wr * 64 + m * 16 + fr; const size_t off = (size_t)rr * D + col0; const size_t moff = (size_t)(rr & (NMETA - 1)) * D + col0;
#pragma unroll
                for (int bj = 0; bj < 2; ++bj)
#pragma unroll
                    for (int n = 0; n < 2; ++n) { const f32x4 bs = *(const f32x4*)(meta + moff + bj * HALF + n * 4); *(f32x4*)(h1meta + off + bj * HALF + n * 4) = bs + acc[0][bj][m][n]; } }
        }
    }
};
__device__ __forceinline__ unsigned pack4_fp8(const f32x4 v) { int w = __builtin_amdgcn_cvt_pk_fp8_f32(v[0], v[1], 0, false); w = __builtin_amdgcn_cvt_pk_fp8_f32(v[2], v[3], w, true); return (unsigned)w; }
struct EpiSwiglu {
    static constexpr bool PERM = true; static constexpr int WSCALE = 0x79797979;
    unsigned char* H;
    __device__ __forceinline__ void operator()(const f32x4 (&acc)[2][2][4][2], const Unit& u, int wr, int wc, int fr, int fq) const {
        typedef unsigned u32x2 __attribute__((ext_vector_type(2)));
        const int colb = (u.pn & 15) * 128 + wc * 32 + 8 * fq;
#pragma unroll
        for (int ai = 0; ai < 2; ++ai)
#pragma unroll
            for (int m = 0; m < 4; ++m) { f32x4 h[2];
#pragma unroll
                for (int n = 0; n < 2; ++n) { const f32x4 a = acc[ai][0][m][n], b = acc[ai][1][m][n];
#pragma unroll
                    for (int i = 0; i < 4; ++i) h[n][i] = a[i] * __builtin_amdgcn_rcpf(1.0f + __builtin_amdgcn_exp2f(-1.4426950408889634f * a[i])) * b[i]; }
                *(u32x2*)(H + (size_t)(u.pm * BM + ai * HALF + wr * 64 + m * 16 + fr) * FF + colb) = (u32x2){pack4_fp8(h[0]), pack4_fp8(h[1])}; }
    }
};
struct EpiDown {
    static constexpr bool PERM = true; static constexpr int WSCALE = 0x79797979;
    unsigned char* Y; const float* gate;
    __device__ __forceinline__ void operator()(const f32x4 (&acc)[2][2][4][2], const Unit& u, int wr, int wc, int fr, int fq) const {
        typedef unsigned u32x2 __attribute__((ext_vector_type(2)));
        const int colb = (u.pn & 3) * 256 + wc * 32 + 8 * fq;
#pragma unroll
        for (int ai = 0; ai < 2; ++ai)
#pragma unroll
            for (int m = 0; m < 4; ++m) { const int r = u.pm * BM + ai * HALF + wr * 64 + m * 16 + fr; const float gv = gate[r] * 16.0f;
#pragma unroll
                for (int bj = 0; bj < 2; ++bj) *(u32x2*)(Y + (size_t)r * D + colb + bj * HALF) = (u32x2){pack4_fp8(acc[ai][bj][m][0] * gv), pack4_fp8(acc[ai][bj][m][1] * gv)}; }
    }
};
}
namespace pg8 {
struct ThinAcc { f32x4 v[2]; };
template <bool FP8, class RowF>
__device__ __forceinline__ void thin_gemm(const unsigned char* A, const unsigned char* Bt, int Kb  , int pn_flat, const RowF& rowf, int wid, int lane, ThinAcc& T, int wscale) {
    const int fr = lane & 15, kq = lane >> 4, wc = wid & 3, n = wid >> 2;
    const unsigned char* ap = A + (size_t)rowf(fr) * Kb;
    const int bcol = 32 * wc + 8 * (fr >> 2) + 4 * n + (fr & 3);
    const unsigned char* bp0 = Bt + ((size_t)pn_flat * BM + bcol) * Kb, * bp1 = bp0 + (size_t)HALF * Kb;
    T.v[0] = (f32x4){0.f, 0.f, 0.f, 0.f}; T.v[1] = T.v[0];
    if constexpr (FP8) {
        const int ascale = 0x7f7f7f7f;
#pragma unroll 4
        for (int s = 0; s < Kb / 128; ++s) { const int o = s * 128 + kq * 32;
            const v4i_t a0 = *(const v4i_t*)(ap + o), a1 = *(const v4i_t*)(ap + o + 16), b00 = *(const v4i_t*)(bp0 + o), b01 = *(const v4i_t*)(bp0 + o + 16), b10 = *(const v4i_t*)(bp1 + o), b11 = *(const v4i_t*)(bp1 + o + 16);
            const v8i_t a8 = __builtin_shufflevector(a0, a1, 0, 1, 2, 3, 4, 5, 6, 7), b08 = __builtin_shufflevector(b00, b01, 0, 1, 2, 3, 4, 5, 6, 7), b18 = __builtin_shufflevector(b10, b11, 0, 1, 2, 3, 4, 5, 6, 7);
            T.v[0] = __builtin_amdgcn_mfma_scale_f32_16x16x128_f8f6f4(b08, a8, T.v[0], 0, 0, 0, wscale, 0, ascale);
            T.v[1] = __builtin_amdgcn_mfma_scale_f32_16x16x128_f8f6f4(b18, a8, T.v[1], 0, 0, 0, wscale, 0, ascale); }
    } else {
#pragma unroll 8
        for (int s = 0; s < Kb / 64; ++s) { const int o = s * 64 + kq * 16;
            const bf16x8 a = *(const bf16x8*)(ap + o), b0 = *(const bf16x8*)(bp0 + o), b1 = *(const bf16x8*)(bp1 + o);
            T.v[0] = __builtin_amdgcn_mfma_f32_16x16x32_bf16(b0, a, T.v[0], 0, 0, 0);
            T.v[1] = __builtin_amdgcn_mfma_f32_16x16x32_bf16(b1, a, T.v[1], 0, 0, 0); }
    }
}
typedef unsigned u32x2 __attribute__((ext_vector_type(2)));
__device__ __forceinline__ u32x2 pack4(const f32x4 v) { return (u32x2){cvt_pk_bf16(v[0], v[1]), cvt_pk_bf16(v[2], v[3])}; }
__device__ __forceinline__ void thin_epi_inproj(const ThinAcc& T, int pn, int wid, int lane, bf16_t* Q, bf16_t* Kb, bf16_t* V, bf16_t* U, bf16_t* CB, const float* rcos, const float* rsin, unsigned* kmax) {
    const int fr = lane & 15, fq = lane >> 4, wc = wid & 3, n = wid >> 2, c8 = 8 * fq + 4 * n;
    if (pn < 4) {
        const int sh = (pn & 1) * 4 + wc; const float sc = pn < 2 ? C2 : 1.0f;
        const f32x4 c = *(const f32x4*)(rcos + fr * 32 + c8), s = *(const f32x4*)(rsin + fr * 32 + c8);
        const f32x4 r1 = (T.v[0] * c - T.v[1] * s) * sc, r2 = (T.v[1] * c + T.v[0] * s) * sc;
        const u32x2 o1 = pack4(r1), o2 = pack4(r2);
        if (pn >= 2) {
            const f32x4 q_ = r1 * r1 + r2 * r2; float ps_ = (q_[0] + q_[1]) + (q_[2] + q_[3]); ps_ += __shfl_xor(ps_, 16); ps_ += __shfl_xor(ps_, 32);
#pragma unroll
            for (int m_ = 1; m_ < 16; m_ <<= 1) ps_ = fmaxf(ps_, __shfl_xor(ps_, m_));
            if (lane == 0) for (int b = 0; b < BATCH; ++b) { const unsigned old_ = __hip_atomic_fetch_max(kmax + b * 8 + sh, __float_as_uint(ps_ * 2.04f), __ATOMIC_RELAXED, __HIP_MEMORY_SCOPE_AGENT); asm volatile("" :: "v"(old_)); } }
        for (int b = 0; b < BATCH; ++b) {
            if (pn < 2) { bf16_t* p = Q + (size_t)(RX + NMETA * b + fr) * AW + sh * 64 + c8; *(u32x2*)p = o1; *(u32x2*)(p + 32) = o2; }
            else { bf16_t* p = Kb + ((size_t)((b * 8 + sh) * KV_TILES)) * 4096 + fq * 512 + fr * 8 + 4 * n; *(u32x2*)p = o1; *(u32x2*)(p + 2048) = o2; } }
    } else if (pn < 6) {
        for (int b = 0; b < BATCH; ++b)
#pragma unroll
            for (int bj = 0; bj < 2; ++bj) {
                const unsigned w = pack4_fp8(T.v[bj] * 16.0f);
                unsigned char* p = (unsigned char*)V + ((size_t)((b * 4 + (pn - 4) * 2 + bj) * KV_TILES)) * 8192 + wc * 2048 + ((fr >> 2) & 1) * 1024 + c8 * 16 + (fr >> 3) * 4 + (fr & 3);
                p[0] = (unsigned char)(w & 0xffu); p[16] = (unsigned char)((w >> 8) & 0xffu); p[32] = (unsigned char)((w >> 16) & 0xffu); p[48] = (unsigned char)(w >> 24); }
    } else if (pn < 10) {
        const u32x2 o = pack4(T.v[0] * T.v[1]);
        for (int b = 0; b < BATCH; ++b) *(u32x2*)(U + (size_t)(RX + NMETA * b + fr) * CWID + (pn - 6) * 128 + wc * 32 + c8) = o;
    } else {
        for (int b = 0; b < BATCH; ++b)
#pragma unroll
            for (int bj = 0; bj < 2; ++bj) *(u32x2*)(CB + (size_t)(RX + NMETA * b + fr) * CWID + (pn - 10) * 256 + bj * HALF + wc * 32 + c8) = pack4(T.v[bj]);
    }
}
__device__ __forceinline__ void thin_epi_outproj(const ThinAcc& T, int b, int pn, int wid, int lane, const float* meta, float* h1meta) {
    const int fr = lane & 15, fq = lane >> 4, wc = wid & 3, n = wid >> 2;
#pragma unroll
    for (int bj = 0; bj < 2; ++bj) { const int col = pn * BM + bj * HALF + wc * 32 + 8 * fq + 4 * n;
        *(f32x4*)(h1meta + (size_t)(NMETA * b + fr) * D + col) = *(const f32x4*)(meta + (size_t)fr * D + col) + T.v[bj]; }
}
__device__ __forceinline__ void thin_epi_swiglu(const ThinAcc& T, int e, int ct, int wid, int lane, unsigned char* H) {
    const int fr = lane & 15, fq = lane >> 4, wc = wid & 3, n = wid >> 2; f32x4 h;
#pragma unroll
    for (int i = 0; i < 4; ++i) { const float a = T.v[0][i]; h[i] = a * __builtin_amdgcn_rcpf(1.0f + __builtin_amdgcn_exp2f(-1.4426950408889634f * a)) * T.v[1][i]; }
    *(unsigned*)(H + (size_t)(e * EPAD + 32 * BM + fr) * FF + ct * 128 + wc * 32 + 8 * fq + 4 * n) = pack4_fp8(h);
}
__device__ __forceinline__ void thin_epi_down(const ThinAcc& T, int e, int ct, int wid, int lane, unsigned char* Y, const float* gate) {
    const int fr = lane & 15, fq = lane >> 4, wc = wid & 3, n = wid >> 2; const int r = e * EPAD + 32 * BM + fr; const float gv = gate[r] * 16.0f;
#pragma unroll
    for (int bj = 0; bj < 2; ++bj) *(unsigned*)(Y + (size_t)r * D + ct * 256 + bj * HALF + wc * 32 + 8 * fq + 4 * n) = pack4_fp8(T.v[bj] * gv);
}
}
constexpr size_t al256(size_t x) { return (x + 255) & ~(size_t)255; }
constexpr size_t WS_CTL = 0, CTL_ZERO_BYTES = 65536;
constexpr size_t WS_ROPE = WS_CTL + CTL_ZERO_BYTES;
constexpr size_t SZ_ROPE = al256((size_t)LSEQ * 32 * 4 * 2);
constexpr size_t WS_AFF = WS_ROPE + SZ_ROPE;
constexpr size_t SZ_AFF = al256((size_t)BATCH * NEXP * LSEQ * 4);
constexpr size_t WS_IDX = WS_AFF + SZ_AFF;
constexpr size_t SZ_IDX = al256((size_t)NEXP * EPAD * 4);
constexpr size_t WS_GATE = WS_IDX + SZ_IDX;
constexpr size_t WS_INV = WS_GATE + SZ_IDX;
constexpr size_t SZ_INV = al256((size_t)RV * NEXP * 4);
constexpr size_t WS_PART = WS_INV + SZ_INV;
constexpr size_t SZ_PART = al256((size_t)32 * 7 * 2 * (64 + 4 * 8 * 64) * 4);
constexpr size_t WS_RTAB = WS_PART + SZ_PART;
constexpr size_t SZ_RTAB = al256((size_t)2 * 16 * 1032 * 2 + 1024 * 4);
constexpr size_t WS_H1M = WS_RTAB + SZ_RTAB;
constexpr size_t SZ_H1M = (size_t)BATCH * NMETA * D * 4;
constexpr size_t WS_WIN = al256(WS_H1M + SZ_H1M);
constexpr size_t SZ_WIN = (size_t)NPROJ * D * 2;
constexpr size_t WS_WOUT = WS_WIN + SZ_WIN;
constexpr size_t SZ_WOUT = (size_t)D * D * 2;
constexpr size_t WS_Q = WS_WOUT + SZ_WOUT;
constexpr size_t SZ_QKV = (size_t)RP * AW * 2;
constexpr size_t SZ_KIMG = (size_t)BATCH * 8 * KV_TILES * 8192;
constexpr size_t WS_K = WS_Q + SZ_QKV;
constexpr size_t WS_W1 = WS_K + SZ_KIMG;
constexpr size_t SZ_W1 = (size_t)NEXP * 2 * FF * D * 2;
constexpr size_t WS_Y = WS_WIN;
constexpr size_t SZ_Y = (size_t)NEXP * EPAD * D * 2;
static_assert(WS_W1 + SZ_W1 - WS_Y >= SZ_Y, "Y overlay fits");
constexpr size_t WS_W2 = WS_W1 + SZ_W1;
constexpr size_t SZ_W2 = (size_t)NEXP * D * FF * 2;
constexpr size_t WS_XN = WS_W2 + SZ_W2;
constexpr size_t SZ_XN = (size_t)RP * D * 2;
constexpr size_t WS_V = WS_XN + SZ_XN, WS_U = WS_V + SZ_KIMG, WS_CB = WS_U + SZ_QKV;
constexpr size_t WS_H = WS_XN;
constexpr size_t SZ_H = (size_t)NEXP * EPAD * FF * 2;
constexpr size_t SZ_H8 = (size_t)NEXP * EPAD * FF;
constexpr size_t WS_H1B = WS_H + SZ_H8;
constexpr size_t WS_HN2 = WS_H1B + (size_t)RX * D * 2;
constexpr size_t WS_END = WS_H + SZ_H;
static_assert(WS_HN2 + (size_t)RP * D <= WS_END, "H | H1B | HN2 fit in the H region");
static_assert(WS_CB + SZ_QKV <= WS_END, "H region covers XN, V, U, CB");
static_assert(WS_END <= (size_t)1 << 30, "workspace map fits in 1 GiB");
constexpr int CW_BAR = 1024;
constexpr int CW_KMAX = 8192;

constexpr int RING_OFF = 0, RING_BYTES = 131072;
constexpr int LDS_BYTES = 163840;
constexpr int MISC_OFF = LDS_BYTES - 256;

#define GAS __attribute__((address_space(1)))
#define LAS __attribute__((address_space(3)))
typedef unsigned short bf16;
typedef unsigned v4u __attribute__((ext_vector_type(4)));
typedef unsigned v2u __attribute__((ext_vector_type(2)));
typedef float f32x4 __attribute__((ext_vector_type(4)));
#define LDS_WAIT() asm volatile("s_waitcnt lgkmcnt(0)" ::: "memory")
#define VM_WAIT() asm volatile("s_waitcnt vmcnt(0)" ::: "memory")
__device__ __forceinline__ unsigned pk2(float lo, float hi) { return pg8::cvt_pk_bf16(lo, hi); }
__device__ __forceinline__ float bf_lo(unsigned w) { return __uint_as_float(w << 16); }
__device__ __forceinline__ float bf_hi(unsigned w) { return __uint_as_float(w & 0xffff0000u); }
__device__ __forceinline__ float wave_sum(float v) {
#pragma unroll
    for (int o = 1; o < 64; o <<= 1) v += __shfl_xor(v, o);
    return v;
}
namespace att {
#define ALAS __attribute__((address_space(3)))
typedef unsigned short bf16_t;
typedef short bf16x8 __attribute__((ext_vector_type(8)));
typedef short s16x4 __attribute__((ext_vector_type(4)));
typedef float f32x16 __attribute__((ext_vector_type(16)));
typedef unsigned u32x4 __attribute__((ext_vector_type(4)));
typedef int i32x4 __attribute__((ext_vector_type(4)));
typedef int i32x8 __attribute__((ext_vector_type(8)));
typedef float f32x4_t __attribute__((ext_vector_type(4)));
constexpr int KT = 64, NTILE = 129, SLOT = 16384;
constexpr int OFF_K = 0, OFF_V = 3 * SLOT, OFF_WS = 6 * SLOT, OFF_ONES = OFF_WS + 8 * 256, LDS_BYTES = OFF_ONES + 2048;
__device__ __forceinline__ int crow(int r, int hi) { return (r & 3) + 8 * (r >> 2) + 4 * hi; }
__device__ __forceinline__ unsigned cvtpk(float lo, float hi) { typedef float f32x2_t __attribute__((ext_vector_type(2))); typedef __bf16 bf16x2_t __attribute__((ext_vector_type(2)));
    f32x2_t v = {lo, hi}; bf16x2_t b = __builtin_convertvector(v, bf16x2_t); return __builtin_bit_cast(unsigned, b); }
__device__ __forceinline__ s16x4 vtr(const ALAS char* p) { typedef short v4i16_t __attribute__((ext_vector_type(4))); return __builtin_bit_cast(s16x4, __builtin_amdgcn_ds_read_tr16_b64_v4i16((ALAS v4i16_t*)p)); }
__device__ __forceinline__ float swapmax(float m) { auto rr = __builtin_amdgcn_permlane32_swap(__float_as_uint(m), __float_as_uint(m), false, false); return __builtin_fmaxf(__uint_as_float(rr[0]), __uint_as_float(rr[1])); }
__device__ __forceinline__ float swapsum(float m) { auto rr = __builtin_amdgcn_permlane32_swap(__float_as_uint(m), __float_as_uint(m), false, false); return __uint_as_float(rr[0]) + __uint_as_float(rr[1]); }
__device__ __forceinline__ void glds_k4(const void* sbase, unsigned voff, unsigned lds_dst) { unsigned keep;
    asm volatile("s_mov_b32 %0, m0\n\ts_mov_b32 m0, %3\n\ts_nop 0\n\tglobal_load_lds_dwordx4 %1, %2\n\tglobal_load_lds_dwordx4 %1, %2 offset:1024\n\tglobal_load_lds_dwordx4 %1, %2 offset:2048\n\tglobal_load_lds_dwordx4 %1, %2 offset:3072\n\ts_mov_b32 m0, %0"
                 : "=&s"(keep) : "v"(voff), "s"(sbase), "s"(lds_dst) : "memory"); }
__device__ __forceinline__ void glds_v2(const void* sbase, unsigned voff, unsigned lds_dst) { unsigned keep;
    asm volatile("s_mov_b32 %0, m0\n\ts_mov_b32 m0, %3\n\ts_nop 0\n\tglobal_load_lds_dwordx4 %1, %2\n\tglobal_load_lds_dwordx4 %1, %2 offset:1024\n\ts_mov_b32 m0, %0" : "=&s"(keep) : "v"(voff), "s"(sbase), "s"(lds_dst) : "memory"); }
#define WAITBAR(last) do { if (last) asm volatile("s_waitcnt vmcnt(0) lgkmcnt(0)\n\ts_barrier" ::: "memory"); else if (kwave) asm volatile("s_waitcnt vmcnt(4) lgkmcnt(0)\n\ts_barrier" ::: "memory"); \
        else asm volatile("s_waitcnt vmcnt(2) lgkmcnt(0)\n\ts_barrier" ::: "memory"); } while (0)
#define MX3(a, b, c) __builtin_fmaxf(__builtin_fmaxf((a), (b)), (c))
#define SBAR() __builtin_amdgcn_sched_barrier(0)
#define PIN(x) asm volatile("" : "+v"(x))
#define EX(v) ((MODE & 2) ? (v) * 0.5f : __builtin_amdgcn_exp2f(v))

struct Tensors { const bf16_t *Q, *K, *V; bf16_t* MIX; const float* subg; float lam; const float* kmax; };
constexpr int PART_F32 = 64 + 4 * 8 * 64;
constexpr int META_CHUNKS = 7;
__device__ __forceinline__ void meta_chunk(int c, int& tb, int& te) { tb = c < 5 ? 19 * c : 95 + 17 * (c - 5); te = tb + (c < 5 ? 19 : 17); }


template <int THRL, int MODE = 0>
__device__ __forceinline__ void attn_unit(const Tensors& T, int b, int h, int qrow0, int nvalid, int tb, int te, float* part, ALAS char* shm, const int wid) {
    const int lane = hw_lane(), r32 = lane & 31, hi = lane >> 5;
    const int sub = wid & 1, rg = wid >> 1, rgq = part ? 0 : rg;
    ALAS float* wsf = (ALAS float*)(shm + OFF_WS) + wid * 64;
    const unsigned lds0 = (unsigned)(uintptr_t)shm;
    const bool kwave = wid < 4;
    const char* gsrc = kwave ? (const char*)T.K + ((size_t)((b * 8 + h * 2 + (wid >> 1)) * NTILE)) * 8192 + (wid & 1) * 4096
                             : (const char*)T.V + ((size_t)((b * 4 + h) * NTILE)) * 8192 + (wid - 4) * 2048;
    const int tstride = 8192;
    const unsigned ldst = lds0 + (kwave ? (unsigned)(OFF_K + wid * 4096) : (unsigned)(OFF_V + (wid - 4) * 2048));
    const unsigned lane16 = (unsigned)lane * 16u;
#define ATT_ISSUE(tt, so) do { const char* sb_ = gsrc + (size_t)(tt) * tstride; const unsigned d_ = ldst + (unsigned)(so); \
        if (kwave) glds_k4(sb_, lane16, d_); else glds_v2(sb_, lane16, d_); } while (0)
    if (kwave) { ATT_ISSUE(tb, 0); ATT_ISSUE(tb + 1, SLOT); } else { ATT_ISSUE(tb, 0); }
    bf16x8 qr[4];
    { const bf16_t* qp = T.Q + (size_t)(qrow0 + rgq * 32 + (part ? (r32 & 15) : r32)) * AW + h * 128 + sub * 64 + hi * 8;
#pragma unroll
      for (int d0 = 0; d0 < 4; ++d0) qr[d0] = *(const bf16x8*)(qp + d0 * 16); }
    asm volatile("" : "+v"(qr[0]), "+v"(qr[1]), "+v"(qr[2]), "+v"(qr[3]));
    f32x16 o[4];
#pragma unroll
    for (int d = 0; d < 4; ++d) o[d] = f32x16{};
    float mref = 0.f;
    f32x16 negm = f32x16{}; PIN(negm);
    int sclA = 0x7f7f7f7f, sclB = 0x7b7b7b7b; PIN(sclA); PIN(sclB);
    f32x4_t lacc = f32x4_t{};
    const int lq0 = ((lane & 15) >> 3) * 16 + 4 * (lane >> 4);
    { const unsigned pat_ = (((lane >> 4) & 1) == ((lane & 15) >> 3)) ? 0x38383838u : 0u; const u32x4 pv_ = (u32x4){pat_, pat_, pat_, pat_};
      *(ALAS u32x4*)(shm + OFF_ONES + lane * 16) = pv_; *(ALAS u32x4*)(shm + OFF_ONES + 1024 + lane * 16) = pv_; }
    const ALAS char* onesp = (const ALAS char*)shm + OFF_ONES + lane * 16;
    const ALAS char* kp0 = (const ALAS char*)shm + OFF_K + sub * 8192 + hi * 1024 + r32 * 16;
    const ALAS char* vp0 = (const ALAS char*)shm + OFF_V + hi * 1024 + r32 * 16;
    f32x16 pA0, pA1, pB0, pB1; i32x8 pa = i32x8{};
    bf16x8 kf[4]; i32x8 vfa, vfb;
    WAITBAR(false);
    if (kwave) { ATT_ISSUE(tb + 2, 2 * SLOT); } else { ATT_ISSUE(tb + 1, SLOT); }
    {
#pragma unroll
        for (int d0 = 0; d0 < 4; ++d0) { const bf16x8 k0 = *(const ALAS bf16x8*)(kp0 + d0 * 2048), k1 = *(const ALAS bf16x8*)(kp0 + d0 * 2048 + 512);
            if (d0 == 0) { pA0 = __builtin_amdgcn_mfma_f32_32x32x16_bf16(k0, qr[0], negm, 0, 0, 0); pA1 = __builtin_amdgcn_mfma_f32_32x32x16_bf16(k1, qr[0], negm, 0, 0, 0); }
            else { pA0 = __builtin_amdgcn_mfma_f32_32x32x16_bf16(k0, qr[d0], pA0, 0, 0, 0); pA1 = __builtin_amdgcn_mfma_f32_32x32x16_bf16(k1, qr[d0], pA1, 0, 0, 0); } }
        if (tb == 0) {
#pragma unroll
            for (int r = 8; r < 16; ++r) pA0[r] = -INFINITY;
#pragma unroll
            for (int r = 0; r < 16; ++r) pA1[r] = -INFINITY;
        }
        float rm = __builtin_fmaxf(pA0[0], pA1[0]);
#pragma unroll
        for (int r = 1; r < 16; ++r) rm = __builtin_fmaxf(rm, __builtin_fmaxf(pA0[r], pA1[r]));
        rm = swapmax(rm);
        mref = rm - 2.0f;
#pragma unroll
        for (int r = 0; r < 16; ++r) { pA0[r] = EX(pA0[r] - mref); pA1[r] = EX(pA1[r] - mref); }
#pragma unroll
        for (int r = 0; r < 16; ++r) negm[r] = -mref;
        PIN(negm);
    }
    WAITBAR(false);
    int ks_cur = SLOT, ks_nx2 = 0;
    int vs_prv = 0, vs_nx1 = 2 * SLOT;
#define PK4(P, B, OLD) __builtin_amdgcn_cvt_pk_fp8_f32(P[(B) + 2], P[(B) + 3], __builtin_amdgcn_cvt_pk_fp8_f32(P[B], P[(B) + 1], OLD, false), true)
#define KRD(j) (*(const ALAS bf16x8*)(kp_ + ((j) >> 1) * 2048 + ((j) & 1) * 512))
#define VLD(d) __builtin_shufflevector(*(const ALAS i32x4*)(vp_ + (d) * 2048), *(const ALAS i32x4*)(vp_ + (d) * 2048 + 512), 0, 1, 2, 3, 4, 5, 6, 7)
#define ONESLD() __builtin_shufflevector(*(const ALAS i32x4*)(onesp), *(const ALAS i32x4*)(onesp + 1024), 0, 1, 2, 3, 4, 5, 6, 7)
#define LSUM(B) asm volatile("v_mfma_scale_f32_16x16x128_f8f6f4 %0, %1, %2, %0, %3, %3 op_sel_hi:[0,0,0]" : "+v"(lacc) : "v"(pa), "v"(B), "v"(sclA))
#define PVMFMA(acc, B) asm volatile("v_mfma_scale_f32_32x32x64_f8f6f4 %0, %1, %2, %0, %3, %4 op_sel_hi:[0,0,0]" : "+v"(acc) : "v"(pa), "v"(B), "v"(sclA), "v"(sclB))
#define RECENTER(P0, P1) \
        float pm_ = MX3(P0[0], P0[1], P1[0]), pq_ = MX3(P0[2], P0[3], P1[1]); pm_ = MX3(pm_, P1[2], P1[3]); \
        _Pragma("unroll") for (int r = 4; r < 16; r += 4) { pm_ = MX3(pm_, P0[r], P0[r + 1]); pq_ = MX3(pq_, P0[r + 2], P0[r + 3]); pm_ = MX3(pm_, P1[r], P1[r + 1]); pq_ = MX3(pq_, P1[r + 2], P1[r + 3]); } \
        pm_ = swapmax(__builtin_fminf(__builtin_fmaxf(pm_, pq_), 3.0e38f)); \
        const float dl_ = __builtin_fmaxf(__builtin_amdgcn_logf(pm_) - 2.0f, 0.f), f_ = __builtin_amdgcn_exp2f(-dl_); \
        mref += dl_; \
        _Pragma("unroll") for (int r = 0; r < 16; ++r) { P0[r] = __builtin_fminf(P0[r], 3.0e38f) * f_; P1[r] = __builtin_fminf(P1[r], 3.0e38f) * f_; } \
        pa[0] = PK4(P0, 0, pa[0]); pa[1] = PK4(P0, 4, pa[1]); pa[2] = PK4(P0, 8, pa[2]); pa[3] = PK4(P0, 12, pa[3]); \
        pa[4] = PK4(P1, 0, pa[4]); pa[5] = PK4(P1, 4, pa[5]); pa[6] = PK4(P1, 8, pa[6]); pa[7] = PK4(P1, 12, pa[7]); PIN(pa); \
        _Pragma("unroll") for (int r = 0; r < 16; ++r) negm[r] = -mref; PIN(negm); \
        if (hi == 0) wsf[r32] = f_; \
        asm volatile("s_nop 15\n\ts_nop 15" ::: "memory"); _Pragma("unroll") for (int d = 0; d < 4; ++d) PIN(o[d]); PIN(lacc); \
        _Pragma("unroll") for (int r = 0; r < 4; ++r) lacc[r] *= wsf[lq0 + r]; PIN(lacc); \
        _Pragma("unroll") for (int r = 0; r < 16; ++r) { const float fr_ = wsf[crow(r, hi)]; _Pragma("unroll") for (int d = 0; d < 4; ++d) o[d][r] *= fr_; } \
        _Pragma("unroll") for (int d = 0; d < 4; ++d) PIN(o[d]); asm volatile("s_nop 7" ::: "memory");
#define FILLA(P0, P1, j) do { \
        if ((j) == 0) { pa[0] = PK4(P0, 0, pa[0]); } if ((j) == 1) { pa[1] = PK4(P0, 4, pa[1]); } if ((j) == 2) { pa[2] = PK4(P0, 8, pa[2]); } if ((j) == 3) { pa[3] = PK4(P0, 12, pa[3]); } \
        if ((j) == 4) { pa[4] = PK4(P1, 0, pa[4]); } if ((j) == 5) { pa[5] = PK4(P1, 4, pa[5]); } if ((j) == 6) { pa[6] = PK4(P1, 8, pa[6]); } if ((j) == 7) { pa[7] = PK4(P1, 12, pa[7]); } \
        } while (0)
#define OVF8() ((((((unsigned)pa[0] + 0x02020202u) | ((unsigned)pa[1] + 0x02020202u) | ((unsigned)pa[2] + 0x02020202u)) | (((unsigned)pa[3] + 0x02020202u) | ((unsigned)pa[4] + 0x02020202u) | ((unsigned)pa[5] + 0x02020202u))) \
                | (((unsigned)pa[6] + 0x02020202u) | ((unsigned)pa[7] + 0x02020202u))) & 0x80808080u)
#define GAPA(C0, C1, P0, P1, j) do { \
        if ((j) == 0) C0 = __builtin_amdgcn_mfma_f32_32x32x16_bf16(kf[0], qr[0], negm, 0, 0, 0); \
        else if ((j) == 1) C1 = __builtin_amdgcn_mfma_f32_32x32x16_bf16(kf[1], qr[0], negm, 0, 0, 0); \
        else if (((j) & 1) == 0) C0 = __builtin_amdgcn_mfma_f32_32x32x16_bf16(kf[(j) & 3], qr[(j) >> 1], C0, 0, 0, 0); \
        else C1 = __builtin_amdgcn_mfma_f32_32x32x16_bf16(kf[(j) & 3], qr[(j) >> 1], C1, 0, 0, 0); \
        if ((j) + 4 < 8) kf[(j) & 3] = KRD((j) + 4); \
        FILLA(P0, P1, j); SBAR(); } while (0)
#define GAPB(C0, C1, i) do { \
        if ((i) == 0) PVMFMA(o[0], vfa); if ((i) == 4) PVMFMA(o[1], vfb); if ((i) == 8) PVMFMA(o[2], vfa); if ((i) == 12) PVMFMA(o[3], vfb); \
        if ((i) == 1) vfa = VLD(2); if ((i) == 5) vfb = VLD(3); if ((i) == 9) vfa = ONESLD(); if ((i) == 15) LSUM(vfa); \
        if ((i) < 8) { C0[2 * (i)] = EX(C0[2 * (i)]); C0[2 * (i) + 1] = EX(C0[2 * (i) + 1]); } \
        else { C1[2 * (i) - 16] = EX(C1[2 * (i) - 16]); C1[2 * (i) - 15] = EX(C1[2 * (i) - 15]); } \
        SBAR(); } while (0)
#define STEP(C0, C1, P0, P1, t) do { SBAR(); asm volatile("" : "+s"(wsel)); const bool kw_ = wsel < 4; \
        const ALAS char* kp_ = kp0 + ks_cur; const ALAS char* vp_ = vp0 + vs_prv; \
        kf[0] = KRD(0); kf[1] = KRD(1); kf[2] = KRD(2); kf[3] = KRD(3); SBAR(); \
        if (kw_) { if ((t) + 2 < te) glds_k4(gnext, lane16, ldst + (unsigned)ks_nx2); } else { if ((t) + 1 < te) glds_v2(gnext, lane16, ldst + (unsigned)vs_nx1); } gnext += 8192; \
        SBAR(); \
        GAPA(C0, C1, P0, P1, 0); GAPA(C0, C1, P0, P1, 1); GAPA(C0, C1, P0, P1, 2); GAPA(C0, C1, P0, P1, 3); \
        GAPA(C0, C1, P0, P1, 4); GAPA(C0, C1, P0, P1, 5); vfa = VLD(0); vfb = VLD(1); SBAR(); GAPA(C0, C1, P0, P1, 6); GAPA(C0, C1, P0, P1, 7); \
        if (__builtin_expect(__any(OVF8() != 0u), 0)) { RECENTER(P0, P1); \
            _Pragma("unroll") for (int r = 0; r < 16; ++r) { C0[r] -= dl_; C1[r] -= dl_; } } \
        SBAR(); if (!kw_) { if ((t) + 1 >= te) asm volatile("s_waitcnt vmcnt(0) lgkmcnt(0)\n\ts_barrier" ::: "memory"); else asm volatile("s_waitcnt vmcnt(2) lgkmcnt(0)\n\ts_barrier" ::: "memory"); } SBAR(); \
        GAPB(C0, C1, 0); GAPB(C0, C1, 1); GAPB(C0, C1, 2); GAPB(C0, C1, 3); GAPB(C0, C1, 4); GAPB(C0, C1, 5); GAPB(C0, C1, 6); GAPB(C0, C1, 7); \
        GAPB(C0, C1, 8); GAPB(C0, C1, 9); GAPB(C0, C1, 10); GAPB(C0, C1, 11); GAPB(C0, C1, 12); GAPB(C0, C1, 13); GAPB(C0, C1, 14); GAPB(C0, C1, 15); \
        PIN(C0); PIN(C1); SBAR(); \
        if (kw_) { if ((t) + 2 >= te) asm volatile("s_waitcnt vmcnt(0) lgkmcnt(0)\n\ts_barrier" ::: "memory"); else asm volatile("s_waitcnt vmcnt(4) lgkmcnt(0)\n\ts_barrier" ::: "memory"); } \
        { const int nk_ = ks_cur + SLOT; const int kn_ = nk_ == 3 * SLOT ? 0 : nk_; ks_nx2 = ks_cur; ks_cur = kn_; } \
        { const int nv_ = vs_prv + SLOT; const int vn_ = nv_ == 3 * SLOT ? 0 : nv_; vs_nx1 = vs_prv; vs_prv = vn_; } \
    } while (0)
    const char* gnext = gsrc + (size_t)(tb + (kwave ? 3 : 2)) * 8192;
    int wsel = wid;
#pragma unroll 1
    for (int t = tb + 1; t < te; t += 2) {
        STEP(pB0, pB1, pA0, pA1, t);
        STEP(pA0, pA1, pB0, pB1, t + 1);
    }
    { pa[0] = PK4(pA0, 0, pa[0]); pa[1] = PK4(pA0, 4, pa[1]); pa[2] = PK4(pA0, 8, pa[2]); pa[3] = PK4(pA0, 12, pa[3]); pa[4] = PK4(pA1, 0, pa[4]); pa[5] = PK4(pA1, 4, pa[5]); pa[6] = PK4(pA1, 8, pa[6]); pa[7] = PK4(pA1, 12, pa[7]); PIN(pa);
      if (__any(OVF8() != 0u)) { RECENTER(pA0, pA1); (void)dl_; }
      const ALAS char* vp_ = vp0 + vs_prv;
      vfa = VLD(0); vfb = VLD(1); PVMFMA(o[0], vfa); PVMFMA(o[1], vfb); PIN(vfa); PIN(vfb); vfa = VLD(2); vfb = VLD(3); PVMFMA(o[2], vfa); PVMFMA(o[3], vfb); PIN(vfa); vfa = ONESLD(); LSUM(vfa);
      asm volatile("s_nop 15\n\ts_nop 15" ::: "memory");
#pragma unroll
      for (int d = 0; d < 4; ++d) PIN(o[d]);
      PIN(lacc); }
#undef ATT_ISSUE
#undef PK4
#undef KRD
#undef VLD
#undef PVMFMA
#undef FILLA
#undef OVF8
#undef LSUM
#undef ONESLD
#undef RECENTER
#undef GAPA
#undef GAPB
#undef STEP
    if (part) {
        if (rg == 0) { float* pp = part + (size_t)sub * PART_F32;
            if (hi == 0) pp[r32] = mref;
            if ((lane & 7) == 0) {
#pragma unroll
                for (int r = 0; r < 4; ++r) pp[32 + lq0 + r] = lacc[r]; }
#pragma unroll
            for (int d = 0; d < 4; ++d)
#pragma unroll
                for (int r = 0; r < 8; ++r) pp[64 + (d * 8 + r) * 64 + lane] = o[d][r]; }
        asm volatile("s_waitcnt lgkmcnt(0)\n\ts_barrier" ::: "memory");
        return;
    }
    if ((lane & 7) == 0) {
#pragma unroll
        for (int r = 0; r < 4; ++r) wsf[32 + lq0 + r] = lacc[r]; }
    float rli[16];
#pragma unroll
    for (int r = 0; r < 16; ++r) rli[r] = 1.0f / wsf[32 + crow(r, hi)];
    asm volatile("s_waitcnt lgkmcnt(0)\n\ts_barrier" ::: "memory");
    ALAS float* X = (ALAS float*)shm + (size_t)rg * 4096 + lane;
    if (sub == 1) {
#pragma unroll
        for (int d = 0; d < 4; ++d)
#pragma unroll
            for (int r = 0; r < 16; ++r) X[(d * 16 + r) * 64] = o[d][r] * rli[r] * T.lam;
    }
    asm volatile("s_waitcnt lgkmcnt(0)\n\ts_barrier" ::: "memory");
    if (sub == 0) {
        float ss[16];
#pragma unroll
        for (int r = 0; r < 16; ++r) { float s = 0.f;
#pragma unroll
            for (int d = 0; d < 4; ++d) { const float v = o[d][r] * rli[r] - X[(d * 16 + r) * 64]; o[d][r] = v; s += v * v; }
            ss[r] = s; }
#pragma unroll
        for (int r = 0; r < 16; ++r) {
#pragma unroll
            for (int m = 1; m < 32; m <<= 1) ss[r] += __shfl_xor(ss[r], m);
            ss[r] = rsqrtf(ss[r] * (1.0f / 128.0f) + NORM_EPS) * (1.0f - LAM_INIT); }
        float gg[4];
#pragma unroll
        for (int d = 0; d < 4; ++d) gg[d] = T.subg[d * 32 + r32];
#pragma unroll
        for (int r = 0; r < 16; ++r) { const int rowi = rg * 32 + crow(r, hi);
            if (rowi < nvalid) { bf16_t* op = T.MIX + (size_t)(qrow0 + rowi) * D + h * 128 + r32;
#pragma unroll
                for (int d = 0; d < 4; ++d) { const float y = o[d][r] * ss[r] * gg[d]; op[d * 32] = (bf16_t)(cvtpk(y, y) & 0xffffu); } } }
    }
    asm volatile("s_waitcnt lgkmcnt(0)\n\ts_barrier" ::: "memory");
}

__device__ __forceinline__ void meta_combine(const Tensors& T, const float* parts, int bh, int lane) {
    const int r32 = lane & 31, hi = lane >> 5, b = bh >> 2, h = bh & 3;
    float osub[2][4][8];
#pragma unroll
    for (int sub = 0; sub < 2; ++sub) {
        float M[8], L[8];
#pragma unroll
        for (int r = 0; r < 8; ++r) { M[r] = -INFINITY; L[r] = 0.f; }
#pragma unroll
        for (int d = 0; d < 4; ++d)
#pragma unroll
            for (int r = 0; r < 8; ++r) osub[sub][d][r] = 0.f;
#pragma unroll 1
        for (int c = 0; c < META_CHUNKS; ++c) { asm volatile("" ::: "memory"); const float* pp = parts + ((size_t)(bh * META_CHUNKS + c) * 2 + sub) * PART_F32;
#pragma unroll
            for (int r = 0; r < 8; ++r) { const int row = crow(r, hi); const float mc = pp[row], lc = pp[32 + row];
                const float mn = __builtin_fmaxf(M[r], mc), fo = __builtin_amdgcn_exp2f(M[r] - mn), fc = __builtin_amdgcn_exp2f(mc - mn);
                M[r] = mn; L[r] = L[r] * fo + lc * fc;
#pragma unroll
                for (int d = 0; d < 4; ++d) osub[sub][d][r] = osub[sub][d][r] * fo + pp[64 + (d * 8 + r) * 64 + lane] * fc; } }
#pragma unroll
        for (int r = 0; r < 8; ++r) { const float rl = 1.0f / L[r];
#pragma unroll
            for (int d = 0; d < 4; ++d) osub[sub][d][r] *= rl; }
    }
    float gg[4];
#pragma unroll
    for (int d = 0; d < 4; ++d) gg[d] = T.subg[d * 32 + r32];
#pragma unroll
    for (int r = 0; r < 8; ++r) { float v[4], s = 0.f;
#pragma unroll
        for (int d = 0; d < 4; ++d) { v[d] = osub[0][d][r] - T.lam * osub[1][d][r]; s += v[d] * v[d]; }
#pragma unroll
        for (int m = 1; m < 32; m <<= 1) s += __shfl_xor(s, m);
        const float sc = rsqrtf(s * (1.0f / 128.0f) + NORM_EPS) * (1.0f - LAM_INIT);
        bf16_t* op = T.MIX + (size_t)(RMETA + NMETA * b + crow(r, hi)) * D + h * 128 + r32;
#pragma unroll
        for (int d = 0; d < 4; ++d) { const float y = v[d] * sc * gg[d]; op[d * 32] = (bf16_t)(cvtpk(y, y) & 0xffffu); } }
}
#undef MX3
#undef WAITBAR
#undef SBAR
#undef PIN
#undef EX
}
#define XB_TMO      128
#define XB_XCNT(j)  (256  + 64 * (j))
#define XB_XSUB(j)  (1280 + 64 * (j))
#define XB_XGEN(j)  (2304 + 64 * (j))
#define XB_TOP      3328
#define XB_TOPGEN   3392
#define XCD_BAR_WORDS 3456
#define XB_SPIN_CAP (1u << 18)

__device__ __forceinline__ unsigned xb_ld(unsigned* p)              { return __hip_atomic_load(p, __ATOMIC_RELAXED, __HIP_MEMORY_SCOPE_AGENT); }
__device__ __forceinline__ unsigned xb_add(unsigned* p, unsigned v) { return __hip_atomic_fetch_add(p, v, __ATOMIC_RELAXED, __HIP_MEMORY_SCOPE_AGENT); }
__device__ __forceinline__ unsigned xb_xcc_id() { return (unsigned)__builtin_amdgcn_s_getreg((3 << 11) | 20) & 0xFu; }
#define XB_SPIN(cond, bar) do { unsigned _sp = 0; while (cond) { __builtin_amdgcn_s_sleep(1); \
    if ((++_sp & 255u) == 0u) { if (xb_ld(&(bar)[XB_TMO])) break; if (_sp > XB_SPIN_CAP) { atomicAdd(&(bar)[XB_TMO], 1u); break; } } } } while (0)

struct XcdBarrier {
    unsigned* bar; unsigned x;
    volatile LAS unsigned* st;
};

__device__ __forceinline__ XcdBarrier xcd_barrier_post(unsigned* bar, volatile LAS unsigned* st) {
    XcdBarrier b; b.bar = bar; b.x = xb_xcc_id(); b.st = st;
    if (threadIdx.x == 0) (void)xb_add(&bar[XB_XCNT(b.x)], 1u);
    return b;
}
__device__ __forceinline__ void xcd_barrier_complete(unsigned* bar, unsigned x, unsigned& nloc, unsigned& nx) {
    const unsigned G = gridDim.x * gridDim.y * gridDim.z;
    unsigned sum, cnt, mine, sp = 0u;
    for (;;) {
        sum = 0u; cnt = 0u; mine = 0u;
#pragma unroll
        for (unsigned j = 0; j < 16; ++j) { const unsigned c = xb_ld(&bar[XB_XCNT(j)]); sum += c; cnt += (c > 0u) ? 1u : 0u; mine = (j == x) ? c : mine; }
        if (sum == G) break;
        __builtin_amdgcn_s_sleep(1);
        if ((++sp & 255u) == 0u) { if (xb_ld(&bar[XB_TMO])) break; if (sp > XB_SPIN_CAP) { atomicAdd(&bar[XB_TMO], 1u); break; } }
    }
    nloc = mine > 0u ? mine : 1u; nx = cnt > 0u ? cnt : 1u;
}

__device__ __forceinline__ void xcd_barrier(const XcdBarrier& b) {
    asm volatile("s_waitcnt vmcnt(0)" ::: "memory");
    __syncthreads();
    if (threadIdx.x == 0) {
        unsigned* bar = b.bar;
        __builtin_amdgcn_s_waitcnt(0);
        unsigned nloc = b.st[0], nx = b.st[1];
        if (nloc == 0u) { xcd_barrier_complete(bar, b.x, nloc, nx); b.st[0] = nloc; b.st[1] = nx; }
        const unsigned old = xb_add(&bar[XB_XSUB(b.x)], 1u);
        const unsigned gen = old / nloc;
        if (old + 1u == (gen + 1u) * nloc) {
            __builtin_amdgcn_fence(__ATOMIC_RELEASE, "agent");
            asm volatile("s_waitcnt vmcnt(0)" ::: "memory");
            const unsigned og = xb_add(&bar[XB_TOP], 1u);
            const unsigned tg = og / nx;
            if (og + 1u == (tg + 1u) * nx) xb_add(&bar[XB_TOPGEN], 1u);
            else XB_SPIN(xb_ld(&bar[XB_TOPGEN]) == tg, bar);
            __builtin_amdgcn_fence(__ATOMIC_ACQUIRE, "agent");
            xb_add(&bar[XB_XGEN(b.x)], 1u);
            asm volatile("s_waitcnt vmcnt(0)" ::: "memory");
        } else {
            XB_SPIN(xb_ld(&bar[XB_XGEN(b.x)]) == gen, bar);
            __builtin_amdgcn_fence(__ATOMIC_ACQUIRE, "agent");
            asm volatile("s_waitcnt vmcnt(0)" ::: "memory");
        }
    }
    __syncthreads();
}
struct Ctx {
    LAS unsigned char* lds; int wave, G, gw, NGW;
    const float* in[17]; float* out; unsigned char* ws;
};
__device__ __forceinline__ int colmap_in(int np) {
    const int pn = np >> 8, c = np & 255, bj = c >> 7, cc = c & 127;
    if (pn < 4) return (pn >> 1) * AW + ((pn & 1) * 4 + (cc >> 5)) * 64 + bj * 32 + (cc & 31);
    if (pn < 6) return 2 * AW + (pn - 4) * 256 + c;
    if (pn < 10) return (bj ? 3 * AW + 2 * CWID : 3 * AW) + (pn - 6) * 128 + cc;
    return 3 * AW + CWID + (pn - 10) * 256 + c;
}
__device__ __forceinline__ void tr_item(const float* W, int N, int k0, int c0, bf16* WT, int r0, int K, LAS float* scr, int lane) {
    float t_[32];
#pragma unroll
    for (int i = 0; i < 32; ++i) t_[i] = W[(size_t)(k0 + 2 * i + (lane >> 5)) * N + c0 + (lane & 31)];
#pragma unroll
    for (int i = 0; i < 32; ++i) scr[(2 * i + (lane >> 5)) * 33 + (lane & 31)] = t_[i];
    LDS_WAIT(); asm volatile("" ::: "memory");
    const int c = lane & 7;
#pragma unroll
    for (int j = 0; j < 4; ++j) { const int n = (lane >> 3) + 8 * j; const LAS float* s = scr + (8 * c) * 33 + n;
        v4u o; o.x = pk2(s[0 * 33], s[1 * 33]); o.y = pk2(s[2 * 33], s[3 * 33]); o.z = pk2(s[4 * 33], s[5 * 33]); o.w = pk2(s[6 * 33], s[7 * 33]);
        *(GAS v4u*)(WT + (size_t)(r0 + n) * K + k0 + 8 * c) = o; }
    LDS_WAIT(); asm volatile("" ::: "memory");
}
__device__ __forceinline__ void tr_item8(const float* W, int N, int k0, int c0, unsigned char* WT, int r0, int K, LAS float* scr, int lane) {
    float t_[32];
#pragma unroll
    for (int i = 0; i < 32; ++i) t_[i] = W[(size_t)(k0 + 2 * i + (lane >> 5)) * N + c0 + (lane & 31)];
#pragma unroll
    for (int i = 0; i < 32; ++i) scr[(2 * i + (lane >> 5)) * 33 + (lane & 31)] = t_[i];
    LDS_WAIT(); asm volatile("" ::: "memory");
    const int c = lane & 3;
#pragma unroll
    for (int j = 0; j < 2; ++j) { const int n = (lane >> 2) + 16 * j; const LAS float* s = scr + (16 * c) * 33 + n; v4u o;
#pragma unroll
        for (int q = 0; q < 4; ++q) { int w = __builtin_amdgcn_cvt_pk_fp8_f32(64.f * s[(4 * q) * 33], 64.f * s[(4 * q + 1) * 33], 0, false);
            w = __builtin_amdgcn_cvt_pk_fp8_f32(64.f * s[(4 * q + 2) * 33], 64.f * s[(4 * q + 3) * 33], w, true); o[q] = (unsigned)w; }
        *(GAS v4u*)(WT + (size_t)(r0 + n) * K + k0 + 16 * c) = o; }
    LDS_WAIT(); asm volatile("" ::: "memory");
}
__device__ __forceinline__ void expert_item(Ctx& F, int it, LAS float* scr, int lane) {
    constexpr int I_GU = 16 * 128, I_DN = 32 * 32, I_E = I_GU + I_DN;
    unsigned char* W1 = F.ws + WS_W1; unsigned char* W2 = F.ws + WS_W2;
    const int e = it / I_E; int r = it - e * I_E;
    if (r < I_GU) { const int kb = r / 128, nb = r % 128, np = 32 * nb, c = np & 255; const float* src = ((c >> 7) ? F.in[14] : F.in[13]) + (size_t)e * D * FF;
        tr_item8(src, FF, 64 * kb, (np >> 8) * 128 + (c & 127), W1 + (size_t)e * 2 * FF * D, np, D, scr, lane); return; } r -= I_GU;
    { const int kb = r / 32, nb = r % 32; tr_item8(F.in[15] + (size_t)e * FF * D, D, 64 * kb, 32 * nb, W2 + (size_t)e * D * FF, 32 * nb, FF, scr, lane); }
}
__device__ __forceinline__ void p0_prologue(Ctx& F) {
    const int lane_ = hw_lane(), tid_ = F.wave * 64 + lane_; (void)tid_;
    LAS float* scr = (LAS float*)(F.lds + RING_OFF + F.wave * 16384);
    bf16* WIN = (bf16*)(F.ws + WS_WIN); bf16* WOUT = (bf16*)(F.ws + WS_WOUT);
    constexpr int I_IN = 16 * 96, I_OUT = 16 * 32, NITEMS = I_IN + I_OUT;
    for (int it = F.gw; it < NITEMS; it += F.NGW) {
        int r = it;
        if (r < I_IN) { const int kb = r / 96, nb = r % 96; tr_item(F.in[3], NPROJ, 64 * kb, colmap_in(32 * nb), WIN, 32 * nb, D, scr, lane_); continue; } r -= I_IN;
        { const int kb = r / 32, nb = r % 32; tr_item(F.in[10], D, 64 * kb, 32 * nb, WOUT, 32 * nb, D, scr, lane_); }
    }
    bf16* XN = (bf16*)(F.ws + WS_XN); const float* gsrc = F.in[2];
    f32x4 gv[4];
#pragma unroll
    for (int j = 0; j < 2; ++j) { gv[2 * j] = *(const GAS f32x4*)(gsrc + 8 * lane_ + 512 * j); gv[2 * j + 1] = *(const GAS f32x4*)(gsrc + 8 * lane_ + 512 * j + 4); }
    for (int r = F.gw; r < RP; r += F.NGW) {
        GAS v4u* o = (GAS v4u*)(XN + (size_t)r * D + 8 * lane_);
        if (r >= RV) { o[0] = (v4u){0u, 0u, 0u, 0u}; o[64] = (v4u){0u, 0u, 0u, 0u}; continue; }
        const float* src = r < RX ? F.in[0] + (size_t)r * D : F.in[1] + (size_t)((r - RX) & (NMETA - 1)) * D;
        f32x4 v[4]; float s = 0.f;
#pragma unroll
        for (int j = 0; j < 2; ++j) { v[2 * j] = *(const GAS f32x4*)(src + 8 * lane_ + 512 * j); v[2 * j + 1] = *(const GAS f32x4*)(src + 8 * lane_ + 512 * j + 4); }
#pragma unroll
        for (int j = 0; j < 4; ++j) s += (v[j].x * v[j].x + v[j].y * v[j].y) + (v[j].z * v[j].z + v[j].w * v[j].w);
        const float rstd = rsqrtf(wave_sum(s) * (1.f / D) + NORM_EPS);
#pragma unroll
        for (int j = 0; j < 2; ++j) { const f32x4 a = v[2 * j] * rstd * gv[2 * j], b = v[2 * j + 1] * rstd * gv[2 * j + 1];
            o[64 * j] = (v4u){pk2(a.x, a.y), pk2(a.z, a.w), pk2(b.x, b.y), pk2(b.z, b.w)}; }
    }
    { char* VI = (char*)(F.ws + WS_V);
      for (int i = F.gw; i < BATCH * 4 * 8; i += F.NGW) { const int bh = i >> 3, q = i & 7;
          *(GAS v4u*)(VI + (size_t)bh * KV_TILES * 8192 + q * 1024 + lane_ * 16) = (v4u){0u, 0u, 0u, 0u}; } }
    { bf16* RT = (bf16*)(F.ws + WS_RTAB); float* RG = (float*)(F.ws + WS_RTAB + (size_t)2 * 16 * 1032 * 2); const float* wr = F.in[12]; const float* gs = F.in[11];
      for (int i = F.gw * 64 + lane_; i < D * NEXP; i += F.NGW * 64) { const int k = i >> 4, e = i & 15; const float w = wr[i] * gs[k];
          const unsigned hb = pk2(w, w) & 0xffffu; const float hf = __uint_as_float(hb << 16); const unsigned lb = pk2(w - hf, w - hf) & 0xffffu;
          RT[e * 1032 + k] = (bf16)hb; RT[16 * 1032 + e * 1032 + k] = (bf16)lb; }
      for (int i = F.gw * 64 + lane_; i < D; i += F.NGW * 64) RG[i] = gs[i]; }
    float* rc = (float*)(F.ws + WS_ROPE); float* rs = rc + LSEQ * 32;
    for (int idx = (F.gw * 64 + lane_); idx < LSEQ * 32; idx += F.NGW * 64) {
        const int pos = idx >> 5, i = idx & 31;
        const float inv_freq = exp2f(-(float)i * (13.287712379549449f / 32.0f));
        const double ang = (double)pos * (double)inv_freq;
        const double n = __builtin_rint(ang * 0.15915494309189535);
        double rr = __builtin_fma(-n, 6.283185307179586, ang); rr = __builtin_fma(-n, 2.4492935982947064e-16, rr);
        const double z = rr * rr; double cs = 0.0, sn = 0.0;
        { double tc = 1.0, ts = 1.0;
#pragma unroll
          for (int k = 0; k < 14; ++k) { cs += tc; sn += ts; tc = -tc * z * (1.0 / (double)((2 * k + 1) * (2 * k + 2))); ts = -ts * z * (1.0 / (double)((2 * k + 2) * (2 * k + 3))); } }
        rc[idx] = (float)cs; rs[idx] = (float)(sn * rr);
    }
}
__device__ __forceinline__ void conv_rows(Ctx& F) {
    const int lane_ = hw_lane(), tid_ = F.wave * 64 + lane_; (void)tid_;
    const bf16* U = (const bf16*)(F.ws + WS_U); const bf16* CBb = (const bf16*)(F.ws + WS_CB); bf16* MIX = (bf16*)(F.ws + WS_XN);
    const float* cw = F.in[4]; float w[3][8];
#pragma unroll
    for (int j = 0; j < 3; ++j)
#pragma unroll
        for (int i = 0; i < 8; ++i) w[j][i] = cw[j * CWID + 8 * lane_ + i];
    for (int g = F.gw; g < RV / 4; g += F.NGW) {
        const int r0 = 4 * g; int prev, next;
        if (r0 < RX) { const int b = r0 >> 13, s = r0 & (SEQ - 1); prev = s > 0 ? r0 - 1 : RMETA + NMETA * b + NMETA - 1; next = s + 3 < SEQ - 1 ? r0 + 4 : -1; }
        else { const int m = r0 - RX, b = m >> 4, j = m & (NMETA - 1); prev = j > 0 ? r0 - 1 : -1; next = j + 3 < NMETA - 1 ? r0 + 4 : b * SEQ; }
        const v4u z = (v4u){0u, 0u, 0u, 0u};
        v4u uu[6], cb[4];
        uu[0] = prev >= 0 ? *(const GAS v4u*)(U + (size_t)prev * CWID + 8 * lane_) : z;
#pragma unroll
        for (int q = 0; q < 4; ++q) { uu[1 + q] = *(const GAS v4u*)(U + (size_t)(r0 + q) * CWID + 8 * lane_); cb[q] = *(const GAS v4u*)(CBb + (size_t)(r0 + q) * CWID + 8 * lane_); }
        uu[5] = next >= 0 ? *(const GAS v4u*)(U + (size_t)next * CWID + 8 * lane_) : z;
#pragma unroll
        for (int q = 0; q < 4; ++q) { float o[8];
#pragma unroll
            for (int t = 0; t < 4; ++t) {
                o[2 * t] = bf_lo(cb[q][t]) * (w[0][2 * t] * bf_lo(uu[q][t]) + w[1][2 * t] * bf_lo(uu[q + 1][t]) + w[2][2 * t] * bf_lo(uu[q + 2][t]));
                o[2 * t + 1] = bf_hi(cb[q][t]) * (w[0][2 * t + 1] * bf_hi(uu[q][t]) + w[1][2 * t + 1] * bf_hi(uu[q + 1][t]) + w[2][2 * t + 1] * bf_hi(uu[q + 2][t])); }
            *(GAS v4u*)(MIX + (size_t)(r0 + q) * D + AW + 8 * lane_) = (v4u){pk2(o[0], o[1]), pk2(o[2], o[3]), pk2(o[4], o[5]), pk2(o[6], o[7])}; }
    }
}
__device__ __forceinline__ int p4_item_count(const Ctx& F) { constexpr int ALL = NEXP * (16 * 128 + 32 * 32); return F.G > BATCH * NEXP ? (ALL / F.NGW) * 5 / 6 * F.NGW : ALL; }
__device__ __forceinline__ void p5_idle_items(Ctx& F) {
    constexpr int ALL = NEXP * (16 * 128 + 32 * 32);
    const int first = p4_item_count(F), nw = (F.G - BATCH * NEXP) * (F.NGW / F.G), w = ((int)blockIdx.x - BATCH * NEXP) * (F.NGW / F.G) + F.wave;
    LAS float* scr = (LAS float*)(F.lds + RING_OFF + F.wave * 8448);
    for (int it = first + w; it < ALL; it += nw) expert_item(F, it, scr, hw_lane());
}
__device__ __forceinline__ void p4_norm_router(Ctx& F) {
    const int lane_ = hw_lane(), tid_ = F.wave * 64 + lane_;
    typedef short bf16x8_t __attribute__((ext_vector_type(8)));
    constexpr int WP = D + 8;
    LAS bf16* Wh = (LAS bf16*)(F.lds + RING_OFF); LAS bf16* Wl = Wh + NEXP * WP; LAS float* G = (LAS float*)(F.lds + RING_OFF + 2 * NEXP * WP * 2);
    { const v4u* src = (const v4u*)(F.ws + WS_RTAB); LAS v4u* dst = (LAS v4u*)(F.lds + RING_OFF);
      for (int i = tid_; i < (int)((2 * NEXP * WP * 2 + D * 4) / 16); i += 512) dst[i] = src[i]; }
    __syncthreads();
    unsigned char* HN2 = F.ws + WS_HN2; const bf16* H1B = (const bf16*)(F.ws + WS_H1B); float* AFF = (float*)(F.ws + WS_AFF); const float* H1M = (const float*)(F.ws + WS_H1M);
    const int rl = lane_ & 15, kq = lane_ >> 4;
    constexpr int N_EITEMS_ALL_ = NEXP * (16 * 128 + 32 * 32);
    const int N_EITEMS = p4_item_count(F); const int per_tile = (N_EITEMS / F.NGW + 1) / 2;
    LAS float* escr = (LAS float*)(F.lds + RING_OFF + 70656 + F.wave * 8448);
    int eit = F.gw;
    for (int t = F.gw; t < RV / 16 + F.NGW; t += F.NGW) {
        asm volatile("" ::: "memory");
        if (t >= RV / 16) { for (; eit < N_EITEMS; eit += F.NGW) expert_item(F, eit, escr, lane_); break; }
        const int row = 16 * t + rl;
        const bool xrow = t < RX / 16;
        const bf16* srcb = H1B + (size_t)row * D + 8 * kq; const float* srcf = H1M + (size_t)(xrow ? 0 : row - RX) * D + 8 * kq;
#define P4_LOAD8(s0) do { if (xrow) { _Pragma("unroll") for (int s = 0; s < 8; ++s) xr[s] = *(const GAS v4u*)(srcb + 32 * ((s0) + s)); } \
        else { _Pragma("unroll") for (int s = 0; s < 8; ++s) { const f32x4 a = *(const GAS f32x4*)(srcf + 32 * ((s0) + s)), b2 = *(const GAS f32x4*)(srcf + 32 * ((s0) + s) + 4); \
            xr[s] = (v4u){pk2(a.x, a.y), pk2(a.z, a.w), pk2(b2.x, b2.y), pk2(b2.z, b2.w)}; } } } while (0)
        v4u xr[8];
        f32x4 acc = (f32x4){0.f, 0.f, 0.f, 0.f}; float ss = 0.f;
#pragma unroll 1
        for (int s0 = 0; s0 < 32; s0 += 8) {
            asm volatile("" ::: "memory");
            P4_LOAD8(s0);
#pragma unroll
            for (int s = 0; s < 8; ++s) {
                const bf16x8_t bh = *(const LAS bf16x8_t*)(Wh + rl * WP + 32 * (s0 + s) + 8 * kq), bl = *(const LAS bf16x8_t*)(Wl + rl * WP + 32 * (s0 + s) + 8 * kq);
                const bf16x8_t af = __builtin_bit_cast(bf16x8_t, xr[s]);
                acc = __builtin_amdgcn_mfma_f32_16x16x32_bf16(af, bh, acc, 0, 0, 0);
                acc = __builtin_amdgcn_mfma_f32_16x16x32_bf16(af, bl, acc, 0, 0, 0);
#pragma unroll
                for (int q = 0; q < 4; ++q) { const float lo = bf_lo(xr[s][q]), hi = bf_hi(xr[s][q]); ss += lo * lo + hi * hi; } } }
        ss += __shfl_xor(ss, 16); ss += __shfl_xor(ss, 32);
        const float rstd = rsqrtf(ss * (1.f / D) + NORM_EPS);
        unsigned char* dst = HN2 + (size_t)row * D + 8 * kq;
#pragma unroll 1
        for (int s0 = 0; s0 < 32; s0 += 8) {
            asm volatile("" ::: "memory");
            P4_LOAD8(s0);
#pragma unroll
            for (int s = 0; s < 8; ++s) { const f32x4 g0 = *(const LAS f32x4*)(G + 32 * (s0 + s) + 8 * kq), g1 = *(const LAS f32x4*)(G + 32 * (s0 + s) + 8 * kq + 4);
                int w0 = __builtin_amdgcn_cvt_pk_fp8_f32(bf_lo(xr[s][0]) * rstd * g0.x, bf_hi(xr[s][0]) * rstd * g0.y, 0, false); w0 = __builtin_amdgcn_cvt_pk_fp8_f32(bf_lo(xr[s][1]) * rstd * g0.z, bf_hi(xr[s][1]) * rstd * g0.w, w0, true);
                int w1 = __builtin_amdgcn_cvt_pk_fp8_f32(bf_lo(xr[s][2]) * rstd * g1.x, bf_hi(xr[s][2]) * rstd * g1.y, 0, false); w1 = __builtin_amdgcn_cvt_pk_fp8_f32(bf_lo(xr[s][3]) * rstd * g1.z, bf_hi(xr[s][3]) * rstd * g1.w, w1, true);
                *(GAS v2u*)(dst + 32 * (s0 + s)) = (v2u){(unsigned)w0, (unsigned)w1}; } }
#undef P4_LOAD8
#pragma unroll
        for (int reg = 0; reg < 4; ++reg) { const int rr = 4 * kq + reg; const float lg = acc[reg] * __shfl(rstd, rr);
            float mx = lg;
#pragma unroll
            for (int m = 1; m < 16; m <<= 1) mx = fmaxf(mx, __shfl_xor(mx, m));
            const float ex = expf(lg - mx); float sm = ex;
#pragma unroll
            for (int m = 1; m < 16; m <<= 1) sm += __shfl_xor(sm, m);
            const int r = 16 * t + rr; const int b = r < RX ? r >> 13 : (r - RX) >> 4, pos = r < RX ? NMETA + (r & (SEQ - 1)) : ((r - RX) & (NMETA - 1));
            AFF[((size_t)b * NEXP + rl) * LSEQ + pos] = ex / sm; }
        for (int j = 0; j < per_tile && eit < N_EITEMS; ++j, eit += F.NGW) expert_item(F, eit, escr, lane_);
    }
}
__device__ __forceinline__ void p5_topk(Ctx& F, int job) {
    const int lane_ = hw_lane(), tid_ = F.wave * 64 + lane_; (void)tid_;
    LAS unsigned* hist = (LAS unsigned*)(F.lds + RING_OFF); LAS unsigned* ctl = hist + 256; LAS unsigned* wsum = hist + 512;
    const int b = job >> 4, e = job & 15;
    const float* AFF = (const float*)(F.ws + WS_AFF) + (size_t)job * LSEQ;
    int* IDX = (int*)(F.ws + WS_IDX); float* GATE = (float*)(F.ws + WS_GATE); int* INV = (int*)(F.ws + WS_INV);
    constexpr int PER = 17;
    unsigned key[PER];
#pragma unroll
    for (int k = 0; k < PER; ++k) { const int i = tid_ * PER + k; key[k] = i < LSEQ ? __float_as_uint(AFF[i]) : 0u; }
    unsigned prefix = 0u, need = CAP;
#pragma unroll 1
    for (int p = 0; p < 4; ++p) {
        const int shift = 24 - 8 * p;
        if (tid_ < 256) hist[tid_] = 0u;
        __syncthreads();
        if (p == 0) {
#pragma unroll
            for (int k = 0; k < PER; ++k) { const int i = tid_ * PER + k; const int bin = i < LSEQ ? (int)(key[k] >> 24) : -1;
                unsigned long long act = __ballot(bin >= 0);
                while (act) { const int leader = __builtin_ctzll(act); const int bl = __builtin_amdgcn_readlane(bin, leader); const unsigned long long m = __ballot(bin == bl);
                    if (lane_ == leader) __hip_atomic_fetch_add(&hist[bl], (unsigned)__builtin_popcountll(m), __ATOMIC_RELAXED, __HIP_MEMORY_SCOPE_WORKGROUP);
                    act &= ~m; } }
        } else {
#pragma unroll
            for (int k = 0; k < PER; ++k) { const int i = tid_ * PER + k;
                if (i < LSEQ && (key[k] >> (shift + 8)) == prefix) __hip_atomic_fetch_add(&hist[(key[k] >> shift) & 255u], 1u, __ATOMIC_RELAXED, __HIP_MEMORY_SCOPE_WORKGROUP); }
        }
        __syncthreads();
        if (F.wave == 0) {
            const unsigned c0 = hist[4 * lane_], c1 = hist[4 * lane_ + 1], c2 = hist[4 * lane_ + 2], c3 = hist[4 * lane_ + 3], s = c0 + c1 + c2 + c3;
            unsigned t = s;
#pragma unroll
            for (int o = 1; o < 64; o <<= 1) { const unsigned v = __shfl_down(t, o); if (lane_ + o < 64) t += v; }
            const unsigned above = t - s;
            if (above < need && need <= t) { unsigned cum = above, sel;
                if (cum + c3 >= need) sel = 3; else { cum += c3; if (cum + c2 >= need) sel = 2; else { cum += c2; if (cum + c1 >= need) sel = 1; else { cum += c1; sel = 0; } } }
                ctl[0] = (prefix << 8) | (4u * lane_ + sel); ctl[1] = need - cum; }
        }
        __syncthreads();
        prefix = ctl[0]; need = ctl[1];
        __syncthreads();
    }
    const unsigned T = prefix, need_eq = need;
    unsigned cnt = 0u;
#pragma unroll
    for (int k = 0; k < PER; ++k) { const int i = tid_ * PER + k; if (i < LSEQ) cnt += (key[k] > T ? 65536u : 0u) + (key[k] == T ? 1u : 0u); }
    unsigned inc = cnt;
#pragma unroll
    for (int o = 1; o < 64; o <<= 1) { const unsigned t = __shfl_up(inc, o); if (lane_ >= o) inc += t; }
    if (lane_ == 63) wsum[F.wave] = inc;
    __syncthreads();
    unsigned base = inc - cnt;
    for (int w = 0; w < F.wave; ++w) base += wsum[w];
    unsigned gt_before = base >> 16, eq_before = base & 65535u;
#pragma unroll
    for (int k = 0; k < PER; ++k) { const int i = tid_ * PER + k;
        if (i < LSEQ) {
            const bool isgt = key[k] > T, iseq = key[k] == T; const bool sel = isgt || (iseq && eq_before < need_eq);
            const int m = i < NMETA ? RMETA + NMETA * b + i : b * SEQ + i - NMETA;
            int yrow = -1;
            if (sel) { const unsigned slot = gt_before + (eq_before < need_eq ? eq_before : need_eq); yrow = e * EPAD + b * CAP + (int)slot; IDX[yrow] = m; GATE[yrow] = __uint_as_float(key[k]); }
            INV[(size_t)m * NEXP + e] = yrow;
            gt_before += isgt ? 1u : 0u; eq_before += iseq ? 1u : 0u;
        } }
    if (b == BATCH - 1) for (int t = tid_; t < EPAD - EROWS; t += 512) { IDX[e * EPAD + EROWS + t] = 0; GATE[e * EPAD + EROWS + t] = 0.f; }
    __syncthreads();
}
__device__ __forceinline__ void p8_final(Ctx& F) {
    const int lane_ = hw_lane(), tid_ = F.wave * 64 + lane_; (void)tid_;
    const int* INV = (const int*)(F.ws + WS_INV); const unsigned char* Y = F.ws + WS_Y; const bf16* H1B = (const bf16*)(F.ws + WS_H1B);
    const float* gsrc = F.in[16]; float gv[16];
#pragma unroll
    for (int j = 0; j < 2; ++j)
#pragma unroll
        for (int i = 0; i < 8; ++i) gv[8 * j + i] = gsrc[8 * lane_ + 512 * j + i];
    for (int g = F.gw; g < RX / 4; g += F.NGW) {
        const int r0 = 4 * g;
        const int iv = INV[(size_t)r0 * NEXP + lane_];
        unsigned long long mask = __ballot(iv >= 0);
        float a[4][16];
#pragma unroll
        for (int q = 0; q < 4; ++q)
#pragma unroll
            for (int j = 0; j < 2; ++j) { const v4u w = *(const GAS v4u*)(H1B + (size_t)(r0 + q) * D + 8 * lane_ + 512 * j);
#pragma unroll
                for (int t = 0; t < 4; ++t) { a[q][8 * j + 2 * t] = bf_lo(w[t]); a[q][8 * j + 2 * t + 1] = bf_hi(w[t]); } }
        while (mask) {
            v2u w[4][2]; float on[4];
#pragma unroll
            for (int q = 0; q < 4; ++q) { const unsigned mq = (unsigned)(mask >> (16 * q)) & 0xffffu; const int e = mq ? __builtin_ctz(mq) : 0;
                const int yrow = __builtin_amdgcn_readlane(iv, 16 * q + e); on[q] = mq ? (1.f / 16.f) : 0.f;
                mask &= ~((unsigned long long)(mq ? 1u : 0u) << (16 * q + e));
                const unsigned char* yp = Y + (size_t)(mq ? yrow : 0) * D + 8 * lane_;
                w[q][0] = *(const GAS v2u*)yp; w[q][1] = *(const GAS v2u*)(yp + 512); }
#pragma unroll
            for (int q = 0; q < 4; ++q)
#pragma unroll
                for (int j = 0; j < 2; ++j)
#pragma unroll
                    for (int t = 0; t < 2; ++t) { typedef float f2_t __attribute__((ext_vector_type(2)));
                        const f2_t lo = __builtin_amdgcn_cvt_pk_f32_fp8((int)w[q][j][t], false), hh = __builtin_amdgcn_cvt_pk_f32_fp8((int)w[q][j][t], true);
                        a[q][8 * j + 4 * t] += on[q] * lo.x; a[q][8 * j + 4 * t + 1] += on[q] * lo.y; a[q][8 * j + 4 * t + 2] += on[q] * hh.x; a[q][8 * j + 4 * t + 3] += on[q] * hh.y; }
        }
#pragma unroll
        for (int q = 0; q < 4; ++q) { float s = 0.f;
#pragma unroll
            for (int i = 0; i < 16; ++i) s += a[q][i] * a[q][i];
            const float rstd = rsqrtf(wave_sum(s) * (1.f / D) + NORM_EPS);
            float* row = F.out + (size_t)(r0 + q) * D + 8 * lane_;
#pragma unroll
            for (int j = 0; j < 2; ++j) { *(GAS f32x4*)(row + 512 * j) = (f32x4){a[q][8 * j] * rstd * gv[8 * j], a[q][8 * j + 1] * rstd * gv[8 * j + 1], a[q][8 * j + 2] * rstd * gv[8 * j + 2], a[q][8 * j + 3] * rstd * gv[8 * j + 3]};
                *(GAS f32x4*)(row + 512 * j + 4) = (f32x4){a[q][8 * j + 4] * rstd * gv[8 * j + 4], a[q][8 * j + 5] * rstd * gv[8 * j + 5], a[q][8 * j + 6] * rstd * gv[8 * j + 6], a[q][8 * j + 7] * rstd * gv[8 * j + 7]}; } }
    }
}
constexpr int NWAVES = 8;
#ifndef MK_N_LAUNCHES
#define MK_N_LAUNCHES 1
#endif
constexpr int N_PHASES = 9;
struct Args { const float* in[17]; float* out; unsigned char* ws; int ph_lo, ph_hi; };
static_assert(sizeof(Args) == 17 * 8 + 8 + 8 + 8, "Args has no padding");

__global__ void __launch_bounds__(NWAVES * 64, 2) hymba_fwd(Args args) {
    extern __shared__ __attribute__((aligned(16))) unsigned char lds_raw[];
    Ctx F;
    F.lds = (LAS unsigned char*)lds_raw;
    F.wave = __builtin_amdgcn_readfirstlane((int)threadIdx.x >> 6);
    F.G = gridDim.x; F.gw = blockIdx.x * NWAVES + F.wave; F.NGW = F.G * NWAVES;
#pragma unroll
    for (int i = 0; i < 17; ++i) F.in[i] = args.in[i];
    F.out = args.out; F.ws = args.ws;
    volatile LAS unsigned* MISC = (volatile LAS unsigned*)(F.lds + MISC_OFF);
    { const int l0 = hw_lane(); if (F.wave == 0) MISC[l0] = 0u; }
    __syncthreads();
    unsigned* ctl = (unsigned*)(F.ws + WS_CTL);
    XcdBarrier bar; bar.bar = ctl + CW_BAR; bar.x = 0; bar.st = nullptr;
    if (MK_N_LAUNCHES == 1) bar = xcd_barrier_post(ctl + CW_BAR, MISC + 8);
    const int lo = args.ph_lo, hi = args.ph_hi;
#define IN(k) (lo <= (k) && (k) < hi)
#define SEAM(k) do { if (IN(k) && IN((k) + 1)) xcd_barrier(bar); } while (0)
#ifndef PROBE_REPEAT
#define PROBE_REPEAT -1
#endif
#define REP(k) for (int rep_ = 0; rep_ < ((PROBE_REPEAT == (k)) ? 2 : 1); ++rep_)
#define REPBAR(k) do { if (PROBE_REPEAT == (k) && rep_ == 0) xcd_barrier(bar); } while (0)

    if (IN(0)) { REP(0) { p0_prologue(F); REPBAR(0); } SEAM(0); }

    if (IN(1)) {
        pg8::Gemm g{(const pg8::bf16_t*)(F.ws + WS_XN), (const pg8::bf16_t*)(F.ws + WS_WIN), D};
        pg8::StaticOrder S; S.init(RX / 256, NPROJ / 256, F.G, (int)blockIdx.x);
        pg8::EpiInProj E{(pg8::bf16_t*)(F.ws + WS_Q), (pg8::bf16_t*)(F.ws + WS_K), (pg8::bf16_t*)(F.ws + WS_V), (pg8::bf16_t*)(F.ws + WS_U), (pg8::bf16_t*)(F.ws + WS_CB),
                         (const float*)(F.ws + WS_ROPE), (const float*)(F.ws + WS_ROPE) + LSEQ * 32, ctl + CW_KMAX};
        pg8::RowIdentity AM;
        REP(1) { pg8::gemm_phase<pg8::EpiInProj, pg8::StaticOrder, pg8::RowIdentity, true>(F.lds + RING_OFF, g, S, E, AM, F.wave); REPBAR(1); }
        for (int pn = (int)blockIdx.x; pn < NPROJ / 256; pn += F.G) {
            pg8::ThinAcc T; const int l0 = hw_lane();
            pg8::thin_gemm<false>(F.ws + WS_XN, F.ws + WS_WIN, D * 2, pn, [](int fr) { return RX + fr; }, F.wave, l0, T, 0);
            pg8::thin_epi_inproj(T, pn, F.wave, l0, E.Q, E.Kb, E.V, E.U, E.CB, E.rcos, E.rsin, E.kmax); }
        SEAM(1);
    }

    if (IN(2)) {
        float lam;
        { const int l0 = hw_lane(); const float a = F.in[5][l0] * F.in[6][l0], b2 = F.in[7][l0] * F.in[8][l0];
          lam = expf(wave_sum(a)) - expf(wave_sum(b2)) + LAM_INIT; }
        const att::Tensors T{(const att::bf16_t*)(F.ws + WS_Q), (const att::bf16_t*)(F.ws + WS_K), (const att::bf16_t*)(F.ws + WS_V), (att::bf16_t*)(F.ws + WS_XN), F.in[9], lam, (const float*)(ctl + CW_KMAX)};
        const int c = (int)blockIdx.x;
        float* const parts = (float*)(F.ws + WS_PART);
        REP(2) { for (int i = 0;; ++i) {
            int b, h, qrow0, nvalid, tb = 0, te = att::NTILE; float* part = nullptr;
            if (F.G == 256) {
                const int xcd = c & 7, ci = c >> 3;
                if (i < 8) { const int bh = xcd + 8 * (i >> 1); b = bh >> 2; h = bh & 3; qrow0 = b * SEQ + ((i & 1) * 32 + ci) * 128; nvalid = 128; }
                else if (i == 8 && ci < 4 * att::META_CHUNKS) { const int bh = xcd + 8 * (ci / att::META_CHUNKS), ch = ci % att::META_CHUNKS; b = bh >> 2; h = bh & 3; qrow0 = RMETA + NMETA * b; nvalid = NMETA;
                    att::meta_chunk(ch, tb, te); part = parts + (size_t)(bh * att::META_CHUNKS + ch) * 2 * att::PART_F32; }
                else break;
            } else {
                const long L = (long)i * F.G + c;
                if (L < 2048) { const int bh = (int)(L >> 6); b = bh >> 2; h = bh & 3; qrow0 = b * SEQ + (int)(L & 63) * 128; nvalid = 128; }
                else if (L < 2048 + 32 * att::META_CHUNKS) { const int j = (int)(L - 2048), bh = j / att::META_CHUNKS, ch = j % att::META_CHUNKS; b = bh >> 2; h = bh & 3; qrow0 = RMETA + NMETA * b; nvalid = NMETA;
                    att::meta_chunk(ch, tb, te); part = parts + (size_t)(bh * att::META_CHUNKS + ch) * 2 * att::PART_F32; }
                else break;
            }
            att::attn_unit<8>(T, b, h, qrow0, nvalid, tb, te, part, (ALAS char*)(F.lds + RING_OFF), F.wave);
        } REPBAR(2); }
        REP(20) { conv_rows(F); REPBAR(20); }
        if (IN(3)) xcd_barrier(bar);
        if (F.gw < 32) att::meta_combine(T, parts, F.gw, hw_lane());
        SEAM(2);
    }

    if (IN(3)) {
        pg8::Gemm g{(const pg8::bf16_t*)(F.ws + WS_XN), (const pg8::bf16_t*)(F.ws + WS_WOUT), D};
        pg8::StaticOrder S; S.init(RX / 256, D / 256, F.G, (int)blockIdx.x);
        pg8::EpiOutProj E{F.in[0], F.in[1], (pg8::bf16_t*)(F.ws + WS_H1B), (float*)(F.ws + WS_H1M)};
        pg8::RowIdentity AM;
        REP(3) { pg8::gemm_phase<pg8::EpiOutProj, pg8::StaticOrder, pg8::RowIdentity, true>(F.lds + RING_OFF, g, S, E, AM, F.wave); REPBAR(3); }
        for (int i = (int)blockIdx.x; i < BATCH * (D / 256); i += F.G) {
            pg8::ThinAcc T; const int l0 = hw_lane(), b = i >> 2, pn = i & 3;
            pg8::thin_gemm<false>(F.ws + WS_XN, F.ws + WS_WOUT, D * 2, pn, [b](int fr) { return RX + NMETA * b + fr; }, F.wave, l0, T, 0);
            pg8::thin_epi_outproj(T, b, pn, F.wave, l0, F.in[1], (float*)(F.ws + WS_H1M)); }
        SEAM(3);
    }

    if (IN(4)) { REP(4) { p4_norm_router(F); REPBAR(4); } SEAM(4); }

    if (IN(5)) { REP(5) { for (int job = (int)blockIdx.x; job < BATCH * NEXP; job += F.G) p5_topk(F, job); REPBAR(5); }
                 if ((int)blockIdx.x >= BATCH * NEXP) p5_idle_items(F);
                 SEAM(5); }

    if (IN(6)) {
        pg8::Gemm g{(const pg8::bf16_t*)(F.ws + WS_HN2), (const pg8::bf16_t*)(F.ws + WS_W1), D / 2};
        pg8::ExpertOrder S; S.init(16, F.G, (int)blockIdx.x);
        pg8::EpiSwiglu E{F.ws + WS_H};
        pg8::RowGather AM{(const int*)(F.ws + WS_IDX)};
        const bool thin_first_ = (((int)blockIdx.x >> 3) & 1) != 0;
        { const bool thin_pass_ = thin_first_;
        for (int i = (int)blockIdx.x; i < NEXP * 16 && thin_pass_; i += F.G) {
            const int e = (F.G == 256) ? 2 * (i & 7) + (i >> 7) : i >> 4, ct = (F.G == 256) ? (i >> 3) & 15 : i & 15;
            pg8::ThinAcc T; const int l0 = hw_lane(); const int* idx = (const int*)(F.ws + WS_IDX) + e * EPAD + 32 * 256;
            pg8::thin_gemm<true>(F.ws + WS_HN2, F.ws + WS_W1, D, e * 16 + ct, [idx](int fr) { return idx[fr]; }, F.wave, l0, T, pg8::EpiSwiglu::WSCALE);
            pg8::thin_epi_swiglu(T, e, ct, F.wave, l0, F.ws + WS_H); }
        }
        REP(6) { pg8::gemm_phase<pg8::EpiSwiglu, pg8::ExpertOrder, pg8::RowGather, true, true>(F.lds + RING_OFF, g, S, E, AM, F.wave); REPBAR(6); }
        { const bool thin_pass_ = !thin_first_;
        for (int i = (int)blockIdx.x; i < NEXP * 16 && thin_pass_; i += F.G) {
            const int e = (F.G == 256) ? 2 * (i & 7) + (i >> 7) : i >> 4, ct = (F.G == 256) ? (i >> 3) & 15 : i & 15;
            pg8::ThinAcc T; const int l0 = hw_lane(); const int* idx = (const int*)(F.ws + WS_IDX) + e * EPAD + 32 * 256;
            pg8::thin_gemm<true>(F.ws + WS_HN2, F.ws + WS_W1, D, e * 16 + ct, [idx](int fr) { return idx[fr]; }, F.wave, l0, T, pg8::EpiSwiglu::WSCALE);
            pg8::thin_epi_swiglu(T, e, ct, F.wave, l0, F.ws + WS_H); }
        }
        SEAM(6);
    }

    if (IN(7)) {
        pg8::Gemm g{(const pg8::bf16_t*)(F.ws + WS_H), (const pg8::bf16_t*)(F.ws + WS_W2), FF / 2};
        pg8::ExpertOrder S; S.init(4, F.G, (int)blockIdx.x);
        pg8::EpiDown E{F.ws + WS_Y, (const float*)(F.ws + WS_GATE)};
        pg8::RowIdentity AM;
        REP(7) { pg8::gemm_phase<pg8::EpiDown, pg8::ExpertOrder, pg8::RowIdentity, true, true>(F.lds + RING_OFF, g, S, E, AM, F.wave); REPBAR(7); }
        for (int i = (int)blockIdx.x; i < NEXP * 4; i += F.G) {
            const int e = (F.G == 256) ? 2 * (i & 7) + (i >> 5) : i >> 2, ct = (F.G == 256) ? (i >> 3) & 3 : i & 3;
            pg8::ThinAcc T; const int l0 = hw_lane();
            pg8::thin_gemm<true>(F.ws + WS_H, F.ws + WS_W2, FF, e * 4 + ct, [e](int fr) { return e * EPAD + 32 * 256 + fr; }, F.wave, l0, T, pg8::EpiDown::WSCALE);
            pg8::thin_epi_down(T, e, ct, F.wave, l0, F.ws + WS_Y, (const float*)(F.ws + WS_GATE)); }
        SEAM(7);
    }

    if (IN(8)) { p8_final(F); }
#undef IN
#undef SEAM
}

extern "C" void kernel_launch(void* const* d_in, const int* in_sizes, int n_in, void* d_out, int out_size, void* d_ws, size_t ws_size, hipStream_t stream) {
    static int grid = 0;
    if (grid == 0) {
        if (n_in != 17 || out_size != RX * D || ws_size < WS_END) { fprintf(stderr, "kernel_launch: unexpected shapes (n_in %d, out %d, ws %zu < %zu)\n", n_in, out_size, ws_size, (size_t)WS_END); grid = -1; return; }
        int dev = 0, cus = 0, per_cu = 0;
        if (hipGetDevice(&dev) != hipSuccess || hipDeviceGetAttribute(&cus, hipDeviceAttributeMultiprocessorCount, dev) != hipSuccess) { grid = -1; return; }
        if (hipFuncSetAttribute((const void*)hymba_fwd, hipFuncAttributeMaxDynamicSharedMemorySize, LDS_BYTES) != hipSuccess) { fprintf(stderr, "kernel_launch: hipFuncSetAttribute failed\n"); grid = -1; return; }
        if (hipOccupancyMaxActiveBlocksPerMultiprocessor(&per_cu, (const void*)hymba_fwd, NWAVES * 64, LDS_BYTES) != hipSuccess || per_cu < 1) { fprintf(stderr, "kernel_launch: occupancy query says %d\n", per_cu); }
        (void)hipGetLastError();
        grid = cus;
    }
    if (grid < 0) return;
    (void)in_sizes;
    if (hipMemsetAsync((char*)d_ws + WS_CTL, 0, CTL_ZERO_BYTES, stream) != hipSuccess) return;
    Args a{};
    for (int i = 0; i < 17; ++i) a.in[i] = (const float*)d_in[i];
    a.out = (float*)d_out; a.ws = (unsigned char*)d_ws;
    if (MK_N_LAUNCHES == 1) { a.ph_lo = 0; a.ph_hi = N_PHASES; hipLaunchKernelGGL(hymba_fwd, dim3(grid), dim3(NWAVES * 64), LDS_BYTES, stream, a); }
    else for (int p = 0; p < N_PHASES; ++p) { a.ph_lo = p; a.ph_hi = p + 1; hipLaunchKernelGGL(hymba_fwd, dim3(grid), dim3(NWAVES * 64), LDS_BYTES, stream, a); }
}
```
